# Optimizing an MI355X kernel written in HIP

```python
import math
import jax, jax.numpy as jnp
from jax import lax
import numpy as np

D_MODEL = 2048
BATCH = 2
SEQ = 16384
DEPTH = 2

N_EVEN = (DEPTH + 1) // 2
N_ODD = DEPTH // 2

DN_ALPHA = (2.0 * DEPTH) ** 0.25
DN_BETA = (8.0 * DEPTH) ** -0.25
LN_EPS = 1e-5

CS_BLOCK = 128

POOL_WIDTH = D_MODEL // 2
POOL_WINDOWS = (2, 4, 8, 16)
POOL_GROUPS = len(POOL_WINDOWS)
POOL_GROUP_DIM = POOL_WIDTH // POOL_GROUPS

SB_HEADS = 8
SB_HEAD_DIM = (D_MODEL - POOL_WIDTH) // SB_HEADS
SB_WIDTH = SB_HEADS * SB_HEAD_DIM
SB_BLOCK = 128

EVEN_IN = POOL_WIDTH + 3 * SB_WIDTH
EVEN_MIX = POOL_WIDTH + SB_WIDTH

SGU_WIDTH = D_MODEL
SGU_GROUPS = 8
SGU_GROUP_DIM = SGU_WIDTH // SGU_GROUPS
SGU_CHUNK = 128
ODD_IN = 2 * SGU_WIDTH

FFN_DIM = 5632
N_EXPERTS = 8
TOP_K = 2
EXPERT_DIM = 1408

kernel_name = 'hybrid_pool_stickbreak_sgu_moe_deepnorm'


def layer_norm(x, g, b):
    xf = x.astype(jnp.float32)
    mu = jnp.mean(xf, axis=-1, keepdims=True)
    xc = xf - mu
    var = jnp.mean(xc * xc, axis=-1, keepdims=True)
    y = xc * lax.rsqrt(var + LN_EPS)
    return (y * g.astype(jnp.float32) + b.astype(jnp.float32)).astype(x.dtype)


def block_cumsum(x):
    lead = x.shape[:-1]
    L = x.shape[-1]
    nb = L // CS_BLOCK
    xb = x.astype(jnp.float32).reshape(lead + (nb, CS_BLOCK))
    tri = jnp.triu(jnp.ones((CS_BLOCK, CS_BLOCK), jnp.float32))
    within = jnp.matmul(xb, tri, precision=lax.Precision.HIGHEST)
    totals = within[..., -1]
    stri = jnp.triu(jnp.ones((nb, nb), jnp.float32), k=1)
    prefix = jnp.matmul(totals, stri, precision=lax.Precision.HIGHEST)
    return (within + prefix[..., None]).reshape(lead + (L,))


def swiglu(x, w_gu, w_down):
    gate, up = jnp.split(x @ w_gu, 2, axis=-1)
    return (jax.nn.silu(gate) * up) @ w_down


def pool_mixer(p, pool_w, pool_scale):
    B, S, _ = p.shape
    pf = p.astype(jnp.float32)
    cs = jnp.swapaxes(block_cumsum(jnp.swapaxes(pf, 1, 2)), 1, 2)
    pos = jnp.arange(S)
    outs = []
    for g, w in enumerate(POOL_WINDOWS):
        sl = slice(g * POOL_GROUP_DIM, (g + 1) * POOL_GROUP_DIM)
        c = cs[..., sl]
        lagged = jnp.pad(c, ((0, 0), (w, 0), (0, 0)))[:, :S]
        count = jnp.minimum(pos + 1, w).astype(jnp.float32)[None, :, None]
        outs.append((c - lagged) / count - pf[..., sl])
    d = jnp.stack(outs, axis=2).astype(p.dtype)
    y = jnp.einsum('bsgc,gcd->bsgd', d, pool_w).reshape(B, S, POOL_WIDTH)
    return y * pool_scale


def stick_breaking_attention(q, k, v):
    B, S, H, Dh = q.shape
    qh = jnp.transpose(q, (0, 2, 1, 3))
    kh = jnp.transpose(k, (0, 2, 1, 3))
    vh = jnp.transpose(v, (0, 2, 1, 3))
    n_blocks = S // SB_BLOCK
    scale = 1.0 / math.sqrt(Dh)
    outs = []
    for i in range(n_blocks):
        start = i * SB_BLOCK
        kv_len = start + SB_BLOCK
        qb = qh[:, :, start:kv_len]
        kb = kh[:, :, :kv_len]
        vb = vh[:, :, :kv_len]
        z = jnp.einsum('bhqd,bhkd->bhqk', qb, kb,
                       preferred_element_type=jnp.float32) * scale
        q_pos = start + jnp.arange(SB_BLOCK)
        causal = jnp.arange(kv_len)[None, :] < q_pos[:, None]
        log_not = jnp.where(causal, jax.nn.log_sigmoid(-z), 0.0)
        c = block_cumsum(log_not)
        between = c[..., -1:] - c
        a = jnp.where(causal, jnp.exp(jax.nn.log_sigmoid(z) + between), 0.0)
        outs.append(jnp.einsum('bhqk,bhkd->bhqd', a.astype(vb.dtype), vb))
    o = jnp.concatenate(outs, axis=2)
    return jnp.transpose(o, (0, 2, 1, 3)).reshape(B, S, H * Dh)


def spatial_gating(z, ln_g, ln_b, w_s, b_s):
    B, S, _ = z.shape
    z = jax.nn.gelu(z)
    u, v = jnp.split(z, 2, axis=-1)
    v = layer_norm(v, ln_g, ln_b)
    v = v.reshape(B, S // SGU_CHUNK, SGU_CHUNK, SGU_GROUPS, SGU_GROUP_DIM)
    mask = jnp.tril(jnp.ones((SGU_CHUNK, SGU_CHUNK), dtype=bool))
    w = jnp.where(mask[None], w_s, 0.0).astype(v.dtype)
    mixed = jnp.einsum('gts,bnsgc->bntgc', w, v) + jnp.transpose(b_s)[None, None, :, :, None]
    return u * mixed.reshape(B, S, SGU_WIDTH)


def moe_swiglu(x, w_router, w_gu, w_down):
    B, S, Dm = x.shape
    xt = x.reshape(B * S, Dm)
    logits = jnp.dot(xt, w_router, preferred_element_type=jnp.float32)
    top_vals, top_idx = lax.top_k(logits, TOP_K)
    top_w = jax.nn.softmax(top_vals, axis=-1)
    gates = jnp.sum(jax.nn.one_hot(top_idx, N_EXPERTS, dtype=jnp.float32)
                    * top_w[..., None], axis=1)
    y = jnp.zeros(xt.shape, jnp.float32)
    for e in range(N_EXPERTS):
        y = y + gates[:, e:e + 1] * swiglu(xt, w_gu[e], w_down[e])
    return y.astype(x.dtype).reshape(B, S, Dm)


def _normal(key, shape, scale):
    return jax.random.normal(key, shape, jnp.float32) * scale


def setup_inputs(seed: int = 0) -> dict:
    key = jax.random.key(seed)
    ks = jax.random.split(key, 32)
    D = D_MODEL
    return {
        'x': _normal(ks[0], (BATCH, SEQ, D), 1.0),
        'even_w_in': _normal(ks[1], (N_EVEN, D, EVEN_IN), D ** -0.5),
        'even_pool_w': _normal(ks[2], (N_EVEN, POOL_GROUPS, POOL_GROUP_DIM, POOL_GROUP_DIM), POOL_GROUP_DIM ** -0.5),
        'even_pool_scale': 1.0 + _normal(ks[3], (N_EVEN, POOL_WIDTH), 0.02),
        'even_w_out': _normal(ks[4], (N_EVEN, EVEN_MIX, D), DN_BETA * EVEN_MIX ** -0.5),
        'even_ln1_g': 1.0 + _normal(ks[5], (N_EVEN, D), 0.02),
        'even_ln1_b': _normal(ks[6], (N_EVEN, D), 0.02),
        'even_ffn_w_gu': _normal(ks[7], (N_EVEN, D, 2 * FFN_DIM), D ** -0.5),
        'even_ffn_w_down': _normal(ks[8], (N_EVEN, FFN_DIM, D), DN_BETA * FFN_DIM ** -0.5),
        'even_ln2_g': 1.0 + _normal(ks[9], (N_EVEN, D), 0.02),
        'even_ln2_b': _normal(ks[10], (N_EVEN, D), 0.02),
        'odd_w_in': _normal(ks[11], (N_ODD, D, ODD_IN), D ** -0.5),
        'odd_sgu_ln_g': 1.0 + _normal(ks[12], (N_ODD, SGU_WIDTH), 0.02),
        'odd_sgu_ln_b': _normal(ks[13], (N_ODD, SGU_WIDTH), 0.02),
        'odd_sgu_w': _normal(ks[14], (N_ODD, SGU_GROUPS, SGU_CHUNK, SGU_CHUNK), SGU_CHUNK ** -0.5),
        'odd_sgu_b': 1.0 + _normal(ks[15], (N_ODD, SGU_GROUPS, SGU_CHUNK), 0.02),
        'odd_w_out': _normal(ks[16], (N_ODD, SGU_WIDTH, D), DN_BETA * SGU_WIDTH ** -0.5),
        'odd_ln1_g': 1.0 + _normal(ks[17], (N_ODD, D), 0.02),
        'odd_ln1_b': _normal(ks[18], (N_ODD, D), 0.02),
        'odd_router': _normal(ks[19], (N_ODD, D, N_EXPERTS), D ** -0.5),
        'odd_moe_w_gu': _normal(ks[20], (N_ODD, N_EXPERTS, D, 2 * EXPERT_DIM), D ** -0.5),
        'odd_moe_w_down': _normal(ks[21], (N_ODD, N_EXPERTS, EXPERT_DIM, D), DN_BETA * EXPERT_DIM ** -0.5),
        'odd_ln2_g': 1.0 + _normal(ks[22], (N_ODD, D), 0.02),
        'odd_ln2_b': _normal(ks[23], (N_ODD, D), 0.02),
    }


def reference(x, even_w_in, even_pool_w, even_pool_scale, even_w_out, even_ln1_g, even_ln1_b,
              even_ffn_w_gu, even_ffn_w_down, even_ln2_g, even_ln2_b,
              odd_w_in, odd_sgu_ln_g, odd_sgu_ln_b, odd_sgu_w, odd_sgu_b, odd_w_out,
              odd_ln1_g, odd_ln1_b, odd_router, odd_moe_w_gu, odd_moe_w_down,
              odd_ln2_g, odd_ln2_b):
    B, S, _ = x.shape
    h = x
    for layer in range(DEPTH):
        i = layer // 2
        if layer % 2 == 0:
            proj = h @ even_w_in[i]
            p = proj[..., :POOL_WIDTH]
            q, k, v = jnp.split(proj[..., POOL_WIDTH:], 3, axis=-1)
            q = q.reshape(B, S, SB_HEADS, SB_HEAD_DIM)
            k = k.reshape(B, S, SB_HEADS, SB_HEAD_DIM)
            v = v.reshape(B, S, SB_HEADS, SB_HEAD_DIM)
            mixed = jnp.concatenate(
                [pool_mixer(p, even_pool_w[i], even_pool_scale[i]),
                 stick_breaking_attention(q, k, v)], axis=-1)
            h = layer_norm(DN_ALPHA * h + mixed @ even_w_out[i], even_ln1_g[i], even_ln1_b[i])
            h = layer_norm(DN_ALPHA * h + swiglu(h, even_ffn_w_gu[i], even_ffn_w_down[i]),
                           even_ln2_g[i], even_ln2_b[i])
        else:
            z = h @ odd_w_in[i]
            mixed = spatial_gating(z, odd_sgu_ln_g[i], odd_sgu_ln_b[i], odd_sgu_w[i], odd_sgu_b[i])
            h = layer_norm(DN_ALPHA * h + mixed @ odd_w_out[i], odd_ln1_g[i], odd_ln1_b[i])
            h = layer_norm(DN_ALPHA * h + moe_swiglu(h, odd_router[i], odd_moe_w_gu[i], odd_moe_w_down[i]),
                           odd_ln2_g[i], odd_ln2_b[i])
    return h
```

```cpp
#include <hip/hip_runtime.h>
#include <cstdio>
#include <cstdint>

#define LAS __attribute__((address_space(3)))
#define GAS __attribute__((address_space(1)))
typedef unsigned short bf16;
typedef short bf16x8 __attribute__((ext_vector_type(8)));
typedef short bf16x4 __attribute__((ext_vector_type(4)));
typedef float f32x4 __attribute__((ext_vector_type(4)));
typedef float f32x2 __attribute__((ext_vector_type(2)));
typedef float f32x16 __attribute__((ext_vector_type(16)));
typedef unsigned u32x4 __attribute__((ext_vector_type(4)));
typedef unsigned u32x2 __attribute__((ext_vector_type(2)));
typedef int i32x8 __attribute__((ext_vector_type(8)));

#ifndef MK_PER_PHASE
#define MK_PER_PHASE 0
#endif

constexpr int BATCH = 2, SEQ = 16384, DM = 2048, M = BATCH * SEQ;
constexpr int EVEN_IN = 4096, POOLW = 1024, FFN = 5632, NEXP = 8, EDIM = 1408;
constexpr float LN_EPS = 1e-5f, DN_ALPHA = 1.41421356237309515f;
constexpr int NPHASE = 17;
constexpr int EPAD = 1536;
constexpr int LISTCAP = 32768;
constexpr int MOE_ROWS = 2 * M + 16 * 256;

constexpr size_t MiB = 1u << 20;
constexpr size_t WS_CTL = 0, CTL_ZERO_BYTES = 163840;
constexpr size_t WS_WIN0 = 2 * MiB, WS_WOUT0 = 18 * MiB, WS_WGU = 26 * MiB, WS_WDN = 70 * MiB, WS_WIN1 = 92 * MiB, WS_WOUT1 = 108 * MiB, WS_MGU = 116 * MiB, WS_MDN = 204 * MiB, WS_PW = 248 * MiB;
constexpr size_t WS_XB = 250 * MiB;
constexpr size_t WS_TB = 378 * MiB;
constexpr size_t WS_R = 634 * MiB;
constexpr size_t WS_MISC = 1018 * MiB;
constexpr size_t WS_END = 1024 * MiB;
constexpr size_t WS_PROJ = WS_R, WS_MIX = WS_R + 256 * MiB, WS_HID = WS_R, WS_Z = WS_R, WS_SG = WS_R + 256 * MiB, WS_MHID = WS_R;
constexpr size_t WS_D = WS_TB + 128 * MiB, WS_VST = WS_TB + 192 * MiB, WS_X8 = WS_TB + 128 * MiB;
constexpr size_t WS_LNX = WS_TB + 208 * MiB;
constexpr size_t WS_WTMP = WS_TB + 200 * MiB;
constexpr size_t WS_OPAIR = WS_R + 104 * MiB;
constexpr size_t WS_PPOS = WS_MISC + 4 * MiB;
constexpr size_t WS_LIST = WS_MISC, WS_GATE = WS_MISC + 2 * MiB;
static_assert((size_t)MOE_ROWS * EPAD <= 104 * MiB && 104 * MiB + (size_t)MOE_ROWS * DM * 2 <= 384 * MiB && (size_t)MOE_ROWS * EDIM * 2 <= 384 * MiB && (size_t)M * FFN * 2 <= 384 * MiB, "R region");
constexpr int CW_CNT = 64;
constexpr int CW_PAN = 8192;
constexpr int CW_BAR = 4096;

constexpr int RING_BYTES = 131072;
constexpr int MISC_OFF = RING_BYTES + 320;
constexpr int LNX_OFF = RING_BYTES + 4096;
constexpr int TAB_OFF = RING_BYTES + 1024;
constexpr int LDS_BYTES = 147456;

#define RLX_AGENT __ATOMIC_RELAXED, __HIP_MEMORY_SCOPE_AGENT
#define LDS_WAIT() asm volatile("s_waitcnt lgkmcnt(0)" ::: "memory")

__device__ __forceinline__ unsigned cvt_pk_bf16(float lo, float hi) { unsigned r; asm volatile("v_cvt_pk_bf16_f32 %0, %1, %2" : "=v"(r) : "v"(lo), "v"(hi)); return r; }
#ifndef WT_STORES
#define WT_STORES 0
#endif
__device__ __forceinline__ void st16(void* p, u32x4 v) {
#if WT_STORES
    asm volatile("global_store_dwordx4 %0, %1, off sc1\n\ts_nop 1" :: "v"(p), "v"(v) : "memory");
#else
    *(u32x4*)p = v;
#endif
}
__device__ __forceinline__ void st16f(void* p, f32x4 v) {
#if WT_STORES
    asm volatile("global_store_dwordx4 %0, %1, off sc1\n\ts_nop 1" :: "v"(p), "v"(v) : "memory");
#else
    *(f32x4*)p = v;
#endif
}
__device__ __forceinline__ void st8(void* p, u32x2 v) {
#if WT_STORES
    asm volatile("global_store_dwordx2 %0, %1, off sc1\n\ts_nop 1" :: "v"(p), "v"(v) : "memory");
#else
    *(u32x2*)p = v;
#endif
}
__device__ __forceinline__ float bf_lo(unsigned w) { return __uint_as_float(w << 16); }
__device__ __forceinline__ float bf_hi(unsigned w) { return __uint_as_float(w & 0xffff0000u); }
__device__ __forceinline__ float clamp448(float x) { return __builtin_amdgcn_fmed3f(x, -448.0f, 448.0f); }
__device__ __forceinline__ unsigned pk4_fp8(float a, float b, float c, float d) {
    int w = 0; w = __builtin_amdgcn_cvt_pk_fp8_f32(clamp448(a), clamp448(b), w, false); w = __builtin_amdgcn_cvt_pk_fp8_f32(clamp448(c), clamp448(d), w, true); return (unsigned)w; }
constexpr float S8_X = 16.0f, S8_W1 = 512.0f, S8_H = 16.0f, S8_W2 = 2048.0f;
__device__ __forceinline__ float wave_sum(float v) {
#pragma unroll
    for (int o = 1; o < 64; o <<= 1) v += __shfl_xor(v, o);
    return v;
}
__device__ __forceinline__ float fast_rcp(float x) { return __builtin_amdgcn_rcpf(x); }
__device__ __forceinline__ float silu_f(float g) { return g * fast_rcp(1.0f + __builtin_amdgcn_exp2f(-1.4426950408889634f * g)); }
__device__ __forceinline__ float gelu_tanh_f(float x) { const float y = x * (1.0f + 0.044715f * x * x); return x * fast_rcp(1.0f + __builtin_amdgcn_exp2f(-2.302208198f * y)); }

namespace pg8 {
constexpr int BM = 256, BK = 64, HALF = 128, HTB = HALF * BK * 2, STAGE_BYTES = 8 * HTB, NXCD = 8, WGM = 8;
__host__ __device__ __forceinline__ int lds_byte(int r, int c) { const int st = (r >> 4) * 2 + (c >> 5), rr = r & 15, cc = c & 31, ob = rr * 64 + cc * 2; return st * 1024 + (ob ^ (((ob >> 9) & 1) << 5)); }
__host__ __device__ __forceinline__ void stage_rc(int b, int& R, int& C) { const int st = b / 1024, sb = b % 1024, swz = sb ^ (((sb >> 9) & 1) << 5); R = (st >> 1) * 16 + swz / 64; C = (st & 1) * 32 + (swz % 64) / 2; }
__host__ __device__ __forceinline__ int perm32(int rho) { const int n = rho >> 4, i = rho & 15; return 8 * (i >> 2) + 4 * n + (i & 3); }

struct Unit { int pm, pn, ord; };
struct Gemm { const bf16* A; const bf16* Bt; int K; int lda; };

struct StaticOrder {
    int nM, nN, nwg, G, c;
    __device__ void init(int Mr, int N, int G_, int c_) { nM = Mr / BM; nN = N / BM; nwg = nM * nN; G = G_; c = c_; }
    __device__ bool next(int i, Unit& u) const {
        const long L = (long)i * G + c; if (L >= nwg) return false;
        int wgid = (int)L; { const int q = nwg / NXCD, r = nwg % NXCD, xcd = wgid % NXCD, off = wgid / NXCD; wgid = (xcd < r ? xcd * (q + 1) : r * (q + 1) + (xcd - r) * q) + off; }
        const int nig = WGM * nN, gid = wgid / nig, fm = gid * WGM, gsz = (nM - fm) < WGM ? (nM - fm) : WGM;
        u.pm = fm + ((wgid % nig) % gsz); u.pn = (wgid % nig) / gsz; return true;
    }
    __device__ __forceinline__ int a_row(const Unit&, int, int) const { return 0; }
    __device__ __forceinline__ size_t a_coloff(const Unit&) const { return 0; }
};
struct PanelOrder {
    int c;
    __device__ bool next(int i, Unit& u) const { if (i >= 4) return false; const int x = c & 7, j = c >> 3; u.pm = 16 * x + 4 * i + (j >> 3); u.pn = j & 7; return true; }
    __device__ __forceinline__ int a_row(const Unit&, int, int) const { return 0; }
    __device__ __forceinline__ size_t a_coloff(const Unit&) const { return 0; }
};
struct FoldOrder {
    int c;
    __device__ bool next(int i, Unit& u) const { if (i > 0 || c >= 32) return false; u.pm = c & 7; u.pn = c >> 3; return true; }
    __device__ __forceinline__ int a_row(const Unit&, int, int) const { return 0; }
    __device__ __forceinline__ size_t a_coloff(const Unit& u) const { return (size_t)u.pn * 512; }
};
struct MoeOrder {
    int nM, nN, nwg, G, c, tile0, rep;
    const LAS int* tbase; const LAS int* tcnt; const LAS unsigned char* tileg; const int* list;
    __device__ __forceinline__ bool next(int i, Unit& u) const {
        if (i >= ilim) return false;
        const long L0 = (long)(i + i0) * G + c; if (L0 >= (long)nwg * rep) return false; const long L = L0 % nwg;
        int wgid = (int)L; { const int q = nwg / NXCD, r = nwg % NXCD, xcd = wgid % NXCD, off = wgid / NXCD; wgid = (xcd < r ? xcd * (q + 1) : r * (q + 1) + (xcd - r) * q) + off; }
        const int nig = WGM * nN, gid = wgid / nig, fm = gid * WGM, gsz = (nM - fm) < WGM ? (nM - fm) : WGM;
        const int pm = tile0 + fm + ((wgid % nig) % gsz), pnl = (wgid % nig) / gsz;
        u.pm = pm; u.pn = (int)(tileg[pm] & 7) * nN + pnl; u.ord = i; return true;
    }
    const LAS int* rowtab; int i0, ilim;
    __device__ __forceinline__ int a_row_g(const Unit& u, int r) const {
        const int g = tileg[u.pm], pos = u.pm * 256 + r - tbase[g], c = tcnt[g];
        return list[g * LISTCAP + (pos < c ? pos : c - 1)];
    }
    __device__ __forceinline__ int a_row(const Unit&, int r, int ord) const { return rowtab[ord * 256 + r]; }
    __device__ __forceinline__ size_t a_coloff(const Unit&) const { return 0; }
};

struct EpiBf16 {
    static constexpr bool PERM = true;
    bf16* O; int ldc;
    __device__ __forceinline__ void operator()(const f32x4 (&acc)[2][2][4][2], const Unit& u, int wr, int wc, int fr, int fq) const {
        const int row0 = u.pm * BM + wr * 64 + fr, col0 = u.pn * BM + wc * 32 + 8 * fq;
#pragma unroll
        for (int ai = 0; ai < 2; ++ai)
#pragma unroll
            for (int m = 0; m < 4; ++m) { bf16* rowp = O + (size_t)(row0 + ai * HALF + m * 16) * ldc + col0;
#pragma unroll
                for (int bj = 0; bj < 2; ++bj) { const f32x4 v0 = acc[ai][bj][m][0], v1 = acc[ai][bj][m][1];
                    u32x4 w; w.x = cvt_pk_bf16(v0[0], v0[1]); w.y = cvt_pk_bf16(v0[2], v0[3]); w.z = cvt_pk_bf16(v1[0], v1[1]); w.w = cvt_pk_bf16(v1[2], v1[3]);
                    st16(rowp + bj * HALF, w); } }
    }
};
struct EpiGeluStats {
    static constexpr bool PERM = true;
    bf16* O; f32x2* vst;
    static __device__ __forceinline__ f32x2 gelu2(f32x2 x) {
        const f32x2 CK = {0.044715f * -2.302208198f, 0.044715f * -2.302208198f}, KK = {-2.302208198f, -2.302208198f}, ONE = {1.0f, 1.0f};
        const f32x2 a = x * __builtin_elementwise_fma(x * x, CK, KK);
        const f32x2 d = (f32x2){__builtin_amdgcn_exp2f(a[0]), __builtin_amdgcn_exp2f(a[1])} + ONE;
        return x * (f32x2){fast_rcp(d[0]), fast_rcp(d[1])};
    }
    template <bool ST>
    __device__ __forceinline__ void body(const f32x4 (&acc)[2][2][4][2], const Unit& u, int wr, int wc, int fr, int fq) const {
        const int row0 = u.pm * BM + wr * 64 + fr, col0 = u.pn * BM + wc * 32 + 8 * fq;
#pragma unroll
        for (int ai = 0; ai < 2; ++ai)
#pragma unroll
            for (int m = 0; m < 4; ++m) { const int row = row0 + ai * HALF + m * 16; bf16* rowp = O + (size_t)row * 4096 + col0; f32x2 s1 = {0.f, 0.f}, s2 = {0.f, 0.f};
#pragma unroll
                for (int bj = 0; bj < 2; ++bj) { const f32x4 v0 = acc[ai][bj][m][0], v1 = acc[ai][bj][m][1];
                    const f32x2 y0 = gelu2((f32x2){v0[0], v0[1]}), y1 = gelu2((f32x2){v0[2], v0[3]}), y2 = gelu2((f32x2){v1[0], v1[1]}), y3 = gelu2((f32x2){v1[2], v1[3]});
                    if (ST) { s1 += (y0 + y1) + (y2 + y3); s2 = __builtin_elementwise_fma(y0, y0, s2); s2 = __builtin_elementwise_fma(y1, y1, s2); s2 = __builtin_elementwise_fma(y2, y2, s2); s2 = __builtin_elementwise_fma(y3, y3, s2); }
                    u32x4 w; w.x = cvt_pk_bf16(y0[0], y0[1]); w.y = cvt_pk_bf16(y1[0], y1[1]); w.z = cvt_pk_bf16(y2[0], y2[1]); w.w = cvt_pk_bf16(y3[0], y3[1]);
                    st16(rowp + bj * HALF, w); }
                if (ST) { float t1 = s1[0] + s1[1], t2 = s2[0] + s2[1]; t1 += __shfl_xor(t1, 16); t1 += __shfl_xor(t1, 32); t2 += __shfl_xor(t2, 16); t2 += __shfl_xor(t2, 32);
                    if (fq == 0) vst[(size_t)row * 32 + (u.pn - 8) * 4 + wc] = (f32x2){t1, t2}; } }
    }
    __device__ __forceinline__ void operator()(const f32x4 (&acc)[2][2][4][2], const Unit& u, int wr, int wc, int fr, int fq) const {
        if (u.pn >= 8) body<true>(acc, u, wr, wc, fr, fq); else body<false>(acc, u, wr, wc, fr, fq);
    }
};
struct EpiRes {
    static constexpr bool PERM = true;
    const bf16* res; bf16* T; float asc;
    __device__ __forceinline__ void operator()(const f32x4 (&acc)[2][2][4][2], const Unit& u, int wr, int wc, int fr, int fq) const {
        const int row0 = u.pm * BM + wr * 64 + fr, col0 = u.pn * BM + wc * 32 + 8 * fq;
        u32x4 rr[2][4][2];
#pragma unroll
        for (int ai = 0; ai < 2; ++ai)
#pragma unroll
            for (int m = 0; m < 4; ++m) { const bf16* rp_ = res + (size_t)(row0 + ai * HALF + m * 16) * DM + col0;
#pragma unroll
                for (int bj = 0; bj < 2; ++bj) rr[ai][m][bj] = *(const u32x4*)(rp_ + bj * HALF); }
#pragma unroll
        for (int ai = 0; ai < 2; ++ai)
#pragma unroll
            for (int m = 0; m < 4; ++m) { const size_t off = (size_t)(row0 + ai * HALF + m * 16) * DM + col0;
#pragma unroll
                for (int bj = 0; bj < 2; ++bj) { const u32x4 r = rr[ai][m][bj]; const f32x4 v0 = acc[ai][bj][m][0] * asc, v1 = acc[ai][bj][m][1] * asc;
                    u32x4 w; w.x = cvt_pk_bf16(bf_lo(r.x) * DN_ALPHA + v0[0], bf_hi(r.x) * DN_ALPHA + v0[1]); w.y = cvt_pk_bf16(bf_lo(r.y) * DN_ALPHA + v0[2], bf_hi(r.y) * DN_ALPHA + v0[3]);
                    w.z = cvt_pk_bf16(bf_lo(r.z) * DN_ALPHA + v1[0], bf_hi(r.z) * DN_ALPHA + v1[1]); w.w = cvt_pk_bf16(bf_lo(r.w) * DN_ALPHA + v1[2], bf_hi(r.w) * DN_ALPHA + v1[3]);
                    st16(T + off + bj * HALF, w); } }
    }
};
struct EpiResLn {
    static constexpr bool PERM = true;
    const bf16* res; bf16* XBo; float asc; const float* gam; const float* bet; unsigned long long* slots; unsigned* cnt; LAS unsigned char* sp; unsigned char* X8o;
    __device__ __forceinline__ void operator()(f32x4 (&acc)[2][2][4][2], const Unit& u, int wr, int wc, int fr, int fq) const {
        const int tid = threadIdx.x, lane = tid & 63, wid = tid >> 6;
        const int row0 = u.pm * BM + wr * 64 + fr, col0 = u.pn * BM + wc * 32 + 8 * fq;
        LAS f32x2* Pt = (LAS f32x2*)sp; LAS f32x2* St = (LAS f32x2*)(sp + 8192);
        const f32x2 AL2 = {DN_ALPHA, DN_ALPHA}, AS2 = {asc, asc};
#pragma unroll
        for (int ai = 0; ai < 2; ++ai) { u32x4 rr[4][2];
#pragma unroll
            for (int m = 0; m < 4; ++m) { const bf16* rp_ = res + (size_t)(row0 + ai * HALF + m * 16) * DM + col0;
#pragma unroll
                for (int bj = 0; bj < 2; ++bj) rr[m][bj] = *(const u32x4*)(rp_ + bj * HALF); }
#pragma unroll
            for (int m = 0; m < 4; ++m) { f32x2 p1 = {0.f, 0.f}, p2 = {0.f, 0.f};
#pragma unroll
                for (int bj = 0; bj < 2; ++bj) { const u32x4 r = rr[m][bj];
#pragma unroll
                    for (int q = 0; q < 4; ++q) { const unsigned w = r[q]; const f32x2 x2 = {bf_lo(w), bf_hi(w)}, a2 = {acc[ai][bj][m][q >> 1][2 * (q & 1)], acc[ai][bj][m][q >> 1][2 * (q & 1) + 1]};
                        const f32x2 t2 = __builtin_elementwise_fma(x2, AL2, a2 * AS2);
                        acc[ai][bj][m][q >> 1][2 * (q & 1)] = t2[0]; acc[ai][bj][m][q >> 1][2 * (q & 1) + 1] = t2[1];
                        p1 += t2; p2 = __builtin_elementwise_fma(t2, t2, p2); } }
                float s1 = p1[0] + p1[1], s2 = p2[0] + p2[1];
                s1 += __shfl_xor(s1, 16); s1 += __shfl_xor(s1, 32); s2 += __shfl_xor(s2, 16); s2 += __shfl_xor(s2, 32);
                if (fq == 0) Pt[(ai * HALF + wr * 64 + m * 16 + fr) * 4 + wc] = (f32x2){s1, s2}; }
            asm volatile("" ::: "memory"); }
        asm volatile("s_waitcnt lgkmcnt(0)" ::: "memory"); __builtin_amdgcn_s_barrier(); asm volatile("" ::: "memory");
        if (tid < 256) { const f32x2 a = Pt[tid * 4 + 0], b = Pt[tid * 4 + 1], c = Pt[tid * 4 + 2], d = Pt[tid * 4 + 3];
            const float S1 = (a[0] + b[0]) + (c[0] + d[0]), S2 = (a[1] + b[1]) + (c[1] + d[1]);
            unsigned long long* sl = slots + (size_t)(u.pm * BM + tid) * 8;
            __hip_atomic_store(sl + u.pn, ((unsigned long long)(__float_as_uint(S2) | 1u) << 32) | __float_as_uint(S1), __ATOMIC_RELAXED, __HIP_MEMORY_SCOPE_AGENT);
            unsigned long long wv[8]; unsigned sp_ = 0;
            for (;;) { unsigned ok = 1u;
#pragma unroll
                for (int t = 0; t < 8; ++t) { wv[t] = __hip_atomic_load(sl + t, __ATOMIC_RELAXED, __HIP_MEMORY_SCOPE_AGENT); }
#pragma unroll
                for (int t = 0; t < 8; ++t) ok &= ((unsigned)(wv[t] >> 32) != 0u) ? 1u : 0u;
                if (ok) break;
                __builtin_amdgcn_s_sleep(1); if (++sp_ > (1u << 18)) break; }
            float T1 = 0.f, T2 = 0.f;
#pragma unroll
            for (int t = 0; t < 8; ++t) { T1 += __uint_as_float((unsigned)wv[t]); T2 += __uint_as_float((unsigned)(wv[t] >> 32)); }
            const float mean = T1 * (1.0f / DM), var = fmaxf(T2 * (1.0f / DM) - mean * mean, 0.f);
            St[tid] = (f32x2){mean, 1.0f / sqrtf(var + LN_EPS)}; }
        asm volatile("s_waitcnt vmcnt(0) lgkmcnt(0)" ::: "memory"); __builtin_amdgcn_s_barrier(); asm volatile("" ::: "memory");
#pragma unroll
        for (int bj = 0; bj < 2; ++bj) { const f32x4 g0 = *(const f32x4*)(gam + col0 + bj * HALF), g1 = *(const f32x4*)(gam + col0 + bj * HALF + 4), b0 = *(const f32x4*)(bet + col0 + bj * HALF), b1 = *(const f32x4*)(bet + col0 + bj * HALF + 4);
            const f32x2 G2[4] = {{g0[0], g0[1]}, {g0[2], g0[3]}, {g1[0], g1[1]}, {g1[2], g1[3]}}, B2[4] = {{b0[0], b0[1]}, {b0[2], b0[3]}, {b1[0], b1[1]}, {b1[2], b1[3]}};
            const f32x2 SX2 = {S8_X, S8_X};
            const f32x2 G8[4] = {G2[0] * SX2, G2[1] * SX2, G2[2] * SX2, G2[3] * SX2}, B8[4] = {B2[0] * SX2, B2[1] * SX2, B2[2] * SX2, B2[3] * SX2};
#pragma unroll
            for (int ai = 0; ai < 2; ++ai)
#pragma unroll
                for (int m = 0; m < 4; ++m) { const f32x2 ms = St[ai * HALF + wr * 64 + m * 16 + fr];
                    const f32x2 R2 = {ms[1], ms[1]}, M2 = {-ms[0] * ms[1], -ms[0] * ms[1]};
                    f32x2 t[4], y[4];
#pragma unroll
                    for (int q = 0; q < 4; ++q) { const f32x2 a2 = {acc[ai][bj][m][q >> 1][2 * (q & 1)], acc[ai][bj][m][q >> 1][2 * (q & 1) + 1]};
                        t[q] = __builtin_elementwise_fma(a2, R2, M2); y[q] = __builtin_elementwise_fma(t[q], G2[q], B2[q]); }
                    u32x4 w; w.x = cvt_pk_bf16(y[0][0], y[0][1]); w.y = cvt_pk_bf16(y[1][0], y[1][1]); w.z = cvt_pk_bf16(y[2][0], y[2][1]); w.w = cvt_pk_bf16(y[3][0], y[3][1]);
                    st16(XBo + (size_t)(row0 + ai * HALF + m * 16) * DM + col0 + bj * HALF, w);
                    if (X8o) { f32x2 z[4];
#pragma unroll
                        for (int q = 0; q < 4; ++q) z[q] = __builtin_elementwise_fma(t[q], G8[q], B8[q]);
                        u32x2 w8; w8.x = pk4_fp8(z[0][0], z[0][1], z[1][0], z[1][1]); w8.y = pk4_fp8(z[2][0], z[2][1], z[3][0], z[3][1]);
                        st8(X8o + (size_t)(row0 + ai * HALF + m * 16) * DM + col0 + bj * HALF, w8); } } }
    }
};
struct EpiSwiglu8 {
    static constexpr bool PERM = true;
    unsigned char* H; int ldh, NT; float asc; int zpad;
    __device__ __forceinline__ void operator()(const f32x4 (&acc)[2][2][4][2], const Unit& u, int wr, int wc, int fr, int fq) const {
        const int row0 = u.pm * BM + wr * 64 + fr, col0 = (u.pn % NT) * HALF + wc * 32 + 8 * fq;
        const float cc = asc * asc * S8_H, kk = -1.4426950408889634f * asc, bb = -__builtin_amdgcn_logf(cc), ic = fast_rcp(cc);
        const f32x2 K2 = {kk, kk}, B2 = {bb, bb}, IC2 = {ic, ic};
#pragma unroll
        for (int ai = 0; ai < 2; ++ai)
#pragma unroll
            for (int m = 0; m < 4; ++m) { unsigned char* rowp = H + (size_t)(row0 + ai * HALF + m * 16) * ldh + col0; float o[8];
#pragma unroll
                for (int n = 0; n < 2; ++n)
#pragma unroll
                    for (int h = 0; h < 2; ++h) {
                        const f32x2 g2 = {acc[ai][0][m][n][2 * h], acc[ai][0][m][n][2 * h + 1]}, u2 = {acc[ai][1][m][n][2 * h], acc[ai][1][m][n][2 * h + 1]};
                        const f32x2 a2 = __builtin_elementwise_fma(g2, K2, B2);
                        const f32x2 d2 = (f32x2){__builtin_amdgcn_exp2f(a2[0]), __builtin_amdgcn_exp2f(a2[1])} + IC2;
                        const f32x2 o2 = (g2 * u2) * (f32x2){fast_rcp(d2[0]), fast_rcp(d2[1])};
                        o[4 * n + 2 * h] = o2[0]; o[4 * n + 2 * h + 1] = o2[1]; }
                u32x2 w; w.x = pk4_fp8(o[0], o[1], o[2], o[3]); w.y = pk4_fp8(o[4], o[5], o[6], o[7]);
                st8(rowp, w);
                if (zpad && (u.pn % NT) == NT - 1) { const u32x2 z = {0u, 0u}; st8(rowp + HALF, z); } }
    }
};
struct EpiMoePairs {
    static constexpr bool PERM = true;
    bf16* O; const LAS float* gtab; float asc;
    const LAS int* tbase; const LAS int* tcnt; const LAS unsigned char* tileg;
    __device__ __forceinline__ void operator()(const f32x4 (&acc)[2][2][4][2], const Unit& u, int wr, int wc, int fr, int fq) const {
        const int g = tileg[u.pm], pos0 = u.pm * BM - tbase[g], cnt = tcnt[g];
        const int col0 = (u.pn & 7) * BM + wc * 32 + 8 * fq;
        float gt[2][4];
#pragma unroll
        for (int ai = 0; ai < 2; ++ai)
#pragma unroll
            for (int m = 0; m < 4; ++m) gt[ai][m] = gtab[u.ord * 256 + ai * HALF + wr * 64 + m * 16 + fr];
#pragma unroll
        for (int ai = 0; ai < 2; ++ai)
#pragma unroll
            for (int m = 0; m < 4; ++m) { const int rl = ai * HALF + wr * 64 + m * 16 + fr, pos = pos0 + rl;
                if (pos < cnt) { const float gs = gt[ai][m] * asc; bf16* rowp = O + (size_t)(u.pm * BM + rl) * DM + col0;
#pragma unroll
                    for (int bj = 0; bj < 2; ++bj) { const f32x4 v0 = acc[ai][bj][m][0] * gs, v1 = acc[ai][bj][m][1] * gs;
                        u32x4 w; w.x = cvt_pk_bf16(v0[0], v0[1]); w.y = cvt_pk_bf16(v0[2], v0[3]); w.z = cvt_pk_bf16(v1[0], v1[1]); w.w = cvt_pk_bf16(v1[2], v1[3]);
                        st16(rowp + bj * HALF, w); } } }
    }
};

template <class Epi, class Sched, bool GATHER, bool F8 = false>
__device__ __forceinline__ void gemm_phase(LAS unsigned char* lds, const Gemm g, const Sched& S, const Epi& E) {
    const int tid = threadIdx.x, wid = __builtin_amdgcn_readfirstlane(tid >> 6), lane = tid & 63, wr = wid >> 2, wc = wid & 3, fr = lane & 15, fq = lane >> 4;
    constexpr int ES = F8 ? 1 : 2;
    const int K = g.K, nt = K * ES / (BK * 2), lda = g.lda;
    unsigned voffB[2]; int RA[2], CA[2];
#pragma unroll
    for (int i = 0; i < 2; ++i) { int R, C; stage_rc(tid * 16 + i * 8192, R, C); const int Rb = Epi::PERM ? ((R & ~31) + perm32(R & 31)) : R;
        RA[i] = R; CA[i] = C; voffB[i] = (unsigned)(Rb * K) * ES + (unsigned)C * 2u; }
    const size_t kstep = (size_t)(BK * 2);
    const size_t hstep = (size_t)HALF * K * ES;
    const size_t tstep = 2 * hstep;
    const size_t hstepA = (size_t)HALF * lda * ES, tstepA = 2 * hstepA;
    const unsigned ldsw = (unsigned)wid * 1024u;
    const int aoff = lds_byte(wr * 64 + fr, fq * 8), boff = lds_byte(wc * 32 + fr, fq * 8);
#define PG8_SA(b, h) (((b) * 2 + (h)) * HTB)
#define PG8_SB(b, h) ((4 + (b) * 2 + (h)) * HTB)
#define PG8_STAGE(bufoff, gbase, voff) do { _Pragma("unroll") for (int _i = 0; _i < 2; ++_i) \
        __builtin_amdgcn_global_load_lds((const unsigned*)((const char*)(gbase) + (voff)[_i]), (LAS unsigned*)(lds + (bufoff) + ldsw + _i * 8192), 16, 0, 0); } while (0)
#define PG8_LD8(p) __builtin_bit_cast(i32x8, __builtin_shufflevector(*(const LAS u32x4*)(p), *(const LAS u32x4*)((p) + 1024), 0, 1, 2, 3, 4, 5, 6, 7))
#define PG8_LDA(dst, b, h) do { if (F8) { _Pragma("unroll") for (int m = 0; m < 4; ++m) dst##8[m] = PG8_LD8(lds + PG8_SA(b, h) + aoff + m * 2048); } \
        else { _Pragma("unroll") for (int m = 0; m < 4; ++m) _Pragma("unroll") for (int k = 0; k < 2; ++k) dst[m][k] = *(const LAS bf16x8*)(lds + PG8_SA(b, h) + aoff + m * 2048 + k * 1024); } } while (0)
#define PG8_LDB(dst, b, h) do { if (F8) { _Pragma("unroll") for (int n = 0; n < 2; ++n) dst##8[n] = PG8_LD8(lds + PG8_SB(b, h) + boff + n * 2048); } \
        else { _Pragma("unroll") for (int n = 0; n < 2; ++n) _Pragma("unroll") for (int k = 0; k < 2; ++k) dst[n][k] = *(const LAS bf16x8*)(lds + PG8_SB(b, h) + boff + n * 2048 + k * 1024); } } while (0)
#define PG8_CAT(X) __builtin_shufflevector(__builtin_bit_cast(u32x4, (X)[0]), __builtin_bit_cast(u32x4, (X)[1]), 0, 1, 2, 3, 4, 5, 6, 7)
#define PG8_MMA(ai, bj, At, Bt) do { __builtin_amdgcn_s_setprio(1); \
        if (F8) { _Pragma("unroll") for (int m = 0; m < 4; ++m) _Pragma("unroll") for (int n = 0; n < 2; ++n) \
            asm volatile("v_mfma_scale_f32_16x16x128_f8f6f4 %0, %1, %2, %0, %3, %3 op_sel_hi:[0,0,0]" : "+v"(acc[ai][bj][m][n]) : "v"(Bt##8[n]), "v"(At##8[m]), "v"(one_scale)); } \
        else { _Pragma("unroll") for (int m = 0; m < 4; ++m) _Pragma("unroll") for (int n = 0; n < 2; ++n) _Pragma("unroll") for (int k = 0; k < 2; ++k) \
            acc[ai][bj][m][n] = __builtin_amdgcn_mfma_f32_16x16x32_bf16(Bt[n][k], At[m][k], acc[ai][bj][m][n], 0, 0, 0); } \
        __builtin_amdgcn_s_setprio(0); } while (0)
#define PG8_WAIT_V(n) asm volatile("s_waitcnt vmcnt(" #n ")" ::: "memory")
#define PG8_WAIT_L(n) asm volatile("s_waitcnt lgkmcnt(" #n ")" ::: "memory")
#define PG8_BAR __builtin_amdgcn_s_barrier()
#define PG8_SCHED __builtin_amdgcn_sched_barrier(0)
    Unit cur, nxt; int ui = 0;
    if (!S.next(0, cur)) return;
    f32x4 acc[2][2][4][2];
#pragma unroll
    for (int a = 0; a < 2; ++a)
#pragma unroll
        for (int b = 0; b < 2; ++b)
#pragma unroll
            for (int m = 0; m < 4; ++m)
#pragma unroll
                for (int n = 0; n < 2; ++n) acc[a][b][m][n] = (f32x4){0.f, 0.f, 0.f, 0.f};
    bf16x8 At[4][2], B0[2][2], B1[2][2]; i32x8 At8[4], B08[2], B18[2]; const int one_scale = 0x7f7f7f7f;
    unsigned cv0[2], cv1[2], nv0[2], nv1[2];
#define PG8_ROWS(U, V0, V1, ORD) do { _Pragma("unroll") for (int _i = 0; _i < 2; ++_i) { \
        if (GATHER) { V0[_i] = (unsigned)(S.a_row(U, RA[_i], ORD) * lda) * ES + (unsigned)CA[_i] * 2u; V1[_i] = (unsigned)(S.a_row(U, HALF + RA[_i], ORD) * lda) * ES + (unsigned)CA[_i] * 2u; } \
        else { V0[_i] = (unsigned)(RA[_i] * lda) * ES + (unsigned)CA[_i] * 2u; V1[_i] = 0u; } } } while (0)
#define PG8_STAGE_A(bufoff, gbase, hf, V0, V1) do { if (GATHER) { if (hf) PG8_STAGE(bufoff, gbase, V1); else PG8_STAGE(bufoff, gbase, V0); } \
        else PG8_STAGE(bufoff, (gbase) + ((hf) ? hstepA : 0), V0); } while (0)
    PG8_ROWS(cur, cv0, cv1, 0);
    const char* cA = GATHER ? (const char*)g.A : (const char*)g.A + (size_t)cur.pm * tstepA + S.a_coloff(cur); const char* cB = (const char*)g.Bt + (size_t)cur.pn * tstep;
    PG8_STAGE(PG8_SB(0, 0), cB, voffB); PG8_STAGE(PG8_SB(0, 1), cB + hstep, voffB); PG8_STAGE_A(PG8_SA(0, 0), cA, 0, cv0, cv1); PG8_STAGE_A(PG8_SA(0, 1), cA, 1, cv0, cv1);
    if (wr == 1) PG8_BAR;
    PG8_WAIT_V(2); PG8_BAR;
    PG8_STAGE(PG8_SB(1, 0), cB + kstep, voffB); PG8_STAGE_A(PG8_SA(1, 0), cA + kstep, 0, cv0, cv1); PG8_STAGE(PG8_SB(1, 1), cB + hstep + kstep, voffB);
    PG8_WAIT_V(6); PG8_BAR;
    for (;;) {
        const bool has_next = S.next(ui + 1, nxt);
        const char* nA = GATHER ? (const char*)g.A : (has_next ? (const char*)g.A + (size_t)nxt.pm * tstepA + S.a_coloff(nxt) : cA); const char* nB = has_next ? (const char*)g.Bt + (size_t)nxt.pn * tstep : cB;
        if (GATHER && has_next) PG8_ROWS(nxt, nv0, nv1, ui + 1); else {
#pragma unroll
            for (int _i = 0; _i < 2; ++_i) { nv0[_i] = cv0[_i]; nv1[_i] = cv1[_i]; } }
        for (int t = 0; t < nt; t += 2) {
            const bool last = (t == nt - 2);
            const char* a1 = cA + (size_t)(t + 1) * kstep;
            const char* a2 = last ? nA : cA + (size_t)(t + 2) * kstep; const char* b2 = last ? nB : cB + (size_t)(t + 2) * kstep;
            const char* a3 = a2 + kstep; const char* b3 = b2 + kstep;
            unsigned w0[2], w1[2];
#pragma unroll
            for (int _i = 0; _i < 2; ++_i) { w0[_i] = last ? nv0[_i] : cv0[_i]; w1[_i] = last ? nv1[_i] : cv1[_i]; }
            PG8_LDB(B0, 0, 0); PG8_LDB(B1, 0, 1); PG8_SCHED; PG8_LDA(At, 0, 0); PG8_STAGE_A(PG8_SA(1, 1), a1, 1, cv0, cv1);
            PG8_WAIT_V(8); PG8_WAIT_L(0); PG8_BAR; PG8_MMA(0, 0, At, B0); PG8_MMA(0, 1, At, B1); PG8_BAR; PG8_SCHED;
            PG8_LDA(At, 0, 1); PG8_STAGE(PG8_SB(0, 0), b2, voffB); PG8_STAGE(PG8_SB(0, 1), b2 + hstep, voffB); PG8_STAGE_A(PG8_SA(0, 0), a2, 0, w0, w1);
            PG8_WAIT_V(8); PG8_WAIT_L(0); PG8_BAR; PG8_MMA(1, 0, At, B0); PG8_MMA(1, 1, At, B1); PG8_BAR; PG8_SCHED;
            PG8_LDB(B0, 1, 0); PG8_LDB(B1, 1, 1); PG8_SCHED; PG8_LDA(At, 1, 0); PG8_STAGE_A(PG8_SA(0, 1), a2, 1, w0, w1);
            PG8_WAIT_V(8); PG8_WAIT_L(0); PG8_BAR; PG8_MMA(0, 0, At, B0); PG8_MMA(0, 1, At, B1); PG8_BAR; PG8_SCHED;
            PG8_LDA(At, 1, 1); PG8_STAGE(PG8_SB(1, 0), b3, voffB); PG8_STAGE(PG8_SB(1, 1), b3 + hstep, voffB); PG8_STAGE_A(PG8_SA(1, 0), a3, 0, w0, w1);
            PG8_WAIT_V(8); PG8_WAIT_L(0); PG8_BAR; PG8_MMA(1, 0, At, B0); PG8_MMA(1, 1, At, B1); PG8_BAR; PG8_SCHED;
        }
        if (wr == 0) PG8_BAR;
        if (F8) asm volatile("s_nop 15\n\ts_nop 15" ::: "memory");
        E(acc, cur, wr, wc, fr, fq);
        if (!has_next) break;
#pragma unroll
        for (int a = 0; a < 2; ++a)
#pragma unroll
            for (int b = 0; b < 2; ++b)
#pragma unroll
                for (int m = 0; m < 4; ++m)
#pragma unroll
                    for (int n = 0; n < 2; ++n) acc[a][b][m][n] = (f32x4){0.f, 0.f, 0.f, 0.f};
        cur = nxt; cA = nA; cB = nB; ++ui;
#pragma unroll
        for (int _i = 0; _i < 2; ++_i) { cv0[_i] = nv0[_i]; cv1[_i] = nv1[_i]; }
        if (wr == 1) PG8_BAR;
    }
    PG8_WAIT_V(0);
    PG8_BAR;
#undef PG8_ROWS
#undef PG8_STAGE_A
#undef PG8_SA
#undef PG8_SB
#undef PG8_STAGE
#undef PG8_LDA
#undef PG8_LDB
#undef PG8_MMA
#undef PG8_CAT
#undef PG8_LD8
#undef PG8_WAIT_V
#undef PG8_WAIT_L
#undef PG8_BAR
#undef PG8_SCHED
}
}

#define XB_TMO      128
#define XB_XCNT(j)  (256  + 64 * (j))
#define XB_XSUB(j)  (1280 + 64 * (j))
#define XB_XGEN(j)  (2304 + 64 * (j))
#define XB_TOP      3328
#define XB_TOPGEN   3392
#define XCD_BAR_WORDS 3456
#define XB_SPIN_CAP (1u << 18)
__device__ __forceinline__ unsigned xb_ld(unsigned* p)              { return __hip_atomic_load(p, __ATOMIC_RELAXED, __HIP_MEMORY_SCOPE_AGENT); }
__device__ __forceinline__ unsigned xb_add(unsigned* p, unsigned v) { return __hip_atomic_fetch_add(p, v, __ATOMIC_RELAXED, __HIP_MEMORY_SCOPE_AGENT); }
__device__ __forceinline__ unsigned xb_xcc_id() { return (unsigned)__builtin_amdgcn_s_getreg((3 << 11) | 20) & 0xFu; }
#define XB_SPIN(cond, bar) do { unsigned _sp = 0; while (cond) { __builtin_amdgcn_s_sleep(1); \
    if ((++_sp & 255u) == 0u) { if (xb_ld(&(bar)[XB_TMO])) break; if (_sp > XB_SPIN_CAP) { atomicAdd(&(bar)[XB_TMO], 1u); break; } } } } while (0)
struct XcdBarrier { unsigned* bar; unsigned x; volatile LAS unsigned* st; };
__device__ __forceinline__ XcdBarrier xcd_barrier_post(unsigned* bar, volatile LAS unsigned* st) {
    XcdBarrier b; b.bar = bar; b.x = xb_xcc_id(); b.st = st;
    if (threadIdx.x == 0) (void)xb_add(&bar[XB_XCNT(b.x)], 1u);
    return b;
}
__device__ __forceinline__ void xcd_barrier_complete(unsigned* bar, unsigned x, unsigned& nloc, unsigned& nx) {
    const unsigned G = gridDim.x * gridDim.y * gridDim.z;
    unsigned sum, cnt, mine, sp = 0u;
    for (;;) {
        sum = 0u; cnt = 0u; mine = 0u;
#pragma unroll
        for (unsigned j = 0; j < 16; ++j) { const unsigned c = xb_ld(&bar[XB_XCNT(j)]); sum += c; cnt += (c > 0u) ? 1u : 0u; mine = (j == x) ? c : mine; }
        if (sum == G) break;
        __builtin_amdgcn_s_sleep(1);
        if ((++sp & 255u) == 0u) { if (xb_ld(&bar[XB_TMO])) break; if (sp > XB_SPIN_CAP) { atomicAdd(&bar[XB_TMO], 1u); break; } }
    }
    nloc = mine > 0u ? mine : 1u; nx = cnt > 0u ? cnt : 1u;
}
__device__ __forceinline__ void xcd_barrier(const XcdBarrier& b) {
    asm volatile("s_waitcnt vmcnt(0)" ::: "memory");
    __syncthreads();
    if (threadIdx.x == 0) {
        unsigned* bar = b.bar;
        __builtin_amdgcn_s_waitcnt(0);
        unsigned nloc = b.st[0], nx = b.st[1];
        if (nloc == 0u) { xcd_barrier_complete(bar, b.x, nloc, nx); b.st[0] = nloc; b.st[1] = nx; }
        const unsigned old = xb_add(&bar[XB_XSUB(b.x)], 1u);
        const unsigned gen = old / nloc;
        if (old + 1u == (gen + 1u) * nloc) {
            __builtin_amdgcn_fence(__ATOMIC_RELEASE, "agent");
            asm volatile("s_waitcnt vmcnt(0)" ::: "memory");
            const unsigned og = xb_add(&bar[XB_TOP], 1u);
            const unsigned tg = og / nx;
            if (og + 1u == (tg + 1u) * nx) xb_add(&bar[XB_TOPGEN], 1u);
            else XB_SPIN(xb_ld(&bar[XB_TOPGEN]) == tg, bar);
            __builtin_amdgcn_fence(__ATOMIC_ACQUIRE, "agent");
            xb_add(&bar[XB_XGEN(b.x)], 1u);
            asm volatile("s_waitcnt vmcnt(0)" ::: "memory");
        } else {
            XB_SPIN(xb_ld(&bar[XB_XGEN(b.x)]) == gen, bar);
            __builtin_amdgcn_fence(__ATOMIC_ACQUIRE, "agent");
            asm volatile("s_waitcnt vmcnt(0)" ::: "memory");
        }
    }
    __syncthreads();
}

struct Ctx { LAS unsigned char* lds; int tid, lane, wave, G, wg; };

__device__ __forceinline__ void tr_item(const float* W, int K, int N, bf16* WT, int drow, int k0, int n0, LAS float* scr, int lane) {
    f32x4 tv[8];
#pragma unroll
    for (int i = 0; i < 8; ++i) tv[i] = *(const f32x4*)(W + (size_t)(k0 + 8 * i + (lane >> 3)) * N + n0 + 4 * (lane & 7));
#pragma unroll
    for (int i = 0; i < 8; ++i) { LAS float* d = scr + (8 * i + (lane >> 3)) * 33 + 4 * (lane & 7); d[0] = tv[i][0]; d[1] = tv[i][1]; d[2] = tv[i][2]; d[3] = tv[i][3]; }
    LDS_WAIT(); asm volatile("" ::: "memory");
    const int c = lane & 7;
#pragma unroll
    for (int j = 0; j < 4; ++j) { const int n = (lane >> 3) + 8 * j; const LAS float* s = scr + (8 * c) * 33 + n;
        u32x4 o; o.x = cvt_pk_bf16(s[0 * 33], s[1 * 33]); o.y = cvt_pk_bf16(s[2 * 33], s[3 * 33]); o.z = cvt_pk_bf16(s[4 * 33], s[5 * 33]); o.w = cvt_pk_bf16(s[6 * 33], s[7 * 33]);
        st16(WT + (size_t)(drow + n) * K + k0 + 8 * c, o); }
    LDS_WAIT(); asm volatile("" ::: "memory");
}
__device__ __forceinline__ void tr_item8(const float* W, int K, int N, unsigned char* WT, int drow, int k0, int n0, float sc, LAS float* scr, int lane) {
    f32x4 tv[8];
#pragma unroll
    for (int i = 0; i < 8; ++i) tv[i] = *(const f32x4*)(W + (size_t)(k0 + 8 * i + (lane >> 3)) * N + n0 + 4 * (lane & 7));
#pragma unroll
    for (int i = 0; i < 8; ++i) { LAS float* d = scr + (8 * i + (lane >> 3)) * 33 + 4 * (lane & 7); d[0] = tv[i][0]; d[1] = tv[i][1]; d[2] = tv[i][2]; d[3] = tv[i][3]; }
    LDS_WAIT(); asm volatile("" ::: "memory");
    const int c = lane & 3;
#pragma unroll
    for (int j = 0; j < 2; ++j) { const int n = (lane >> 2) + 16 * j; const LAS float* s = scr + (16 * c) * 33 + n;
        u32x4 o; o.x = pk4_fp8(s[0 * 33] * sc, s[1 * 33] * sc, s[2 * 33] * sc, s[3 * 33] * sc); o.y = pk4_fp8(s[4 * 33] * sc, s[5 * 33] * sc, s[6 * 33] * sc, s[7 * 33] * sc);
        o.z = pk4_fp8(s[8 * 33] * sc, s[9 * 33] * sc, s[10 * 33] * sc, s[11 * 33] * sc); o.w = pk4_fp8(s[12 * 33] * sc, s[13 * 33] * sc, s[14 * 33] * sc, s[15 * 33] * sc);
        st16(WT + (size_t)(drow + n) * K + k0 + 16 * c, o); }
    LDS_WAIT(); asm volatile("" ::: "memory");
}
__device__ __forceinline__ int gu_row(int n, int F) { const int up = n >= F, j = up ? n - F : n; return (j >> 7) * 256 + up * 128 + (j & 127); }

struct Ptrs {
    const float* in[24]; float* out; unsigned char* ws; int ph_lo, ph_hi;
};

__device__ __forceinline__ void p_prologue(const Ctx& C, const Ptrs& P) {
    LAS float* scr = (LAS float*)(C.lds + C.wave * 16384);
    const int gw = C.wg * 8 + C.wave, NGW = C.G * 8;
    unsigned char* ws = P.ws;
    constexpr int I1 = 32 * 128, I2 = 4 * 32, I3 = 32 * 64, I4 = 32 * 352, I5 = 88 * 64, I6 = 32 * 128, I7 = 32 * 64, I8 = 8 * 32 * 88, I9 = 8 * 24 * 64;
    constexpr int NITEMS = I1 + I2 + I3 + I4 + I5 + I6 + I7 + I8 + I9;
    for (int it = gw; it < NITEMS; it += NGW) {
        int r = it;
        if (r < I1) { const int kb = r / 128, nb = r % 128; tr_item(P.in[1], DM, EVEN_IN, (bf16*)(ws + WS_WIN0), 32 * nb, 64 * kb, 32 * nb, scr, C.lane); continue; } r -= I1;
        if (r < I2) { const float* pw = P.in[2] + (size_t)r * 2048; const float* sc = P.in[3] + 256 * (r >> 5); bf16* o = (bf16*)(ws + WS_PW) + (size_t)r * 2048;
#pragma unroll
            for (int i = 0; i < 8; ++i) { const f32x4 a = *(const f32x4*)(pw + 256 * i + 4 * C.lane), b = *(const f32x4*)(sc + 4 * C.lane); u32x2 w; w.x = cvt_pk_bf16(a[0] * b[0], a[1] * b[1]); w.y = cvt_pk_bf16(a[2] * b[2], a[3] * b[3]); *(u32x2*)(o + 256 * i + 4 * C.lane) = w; }
            continue; } r -= I2;
        if (r < I3) { const int kb = r / 64, nb = r % 64;
            if (kb < 16) tr_item(P.in[4], 1024, DM, (bf16*)(ws + WS_WTMP), 32 * nb, 64 * kb, 32 * nb, scr, C.lane);
            else tr_item(P.in[4], DM, DM, (bf16*)(ws + WS_WOUT0), 32 * nb, 64 * kb, 32 * nb, scr, C.lane);
            continue; } r -= I3;
        if (r < I4) { const int kb = r / 352, nb = r % 352; tr_item8(P.in[7], DM, 2 * FFN, ws + WS_WGU, gu_row(32 * nb, FFN), 64 * kb, 32 * nb, S8_W1, scr, C.lane); continue; } r -= I4;
        if (r < I5) { const int kb = r / 64, nb = r % 64; tr_item8(P.in[8], FFN, DM, ws + WS_WDN, 32 * nb, 64 * kb, 32 * nb, S8_W2, scr, C.lane); continue; } r -= I5;
        if (r < I6) { const int kb = r / 128, nb = r % 128; tr_item(P.in[11], DM, 4096, (bf16*)(ws + WS_WIN1), 32 * nb, 64 * kb, 32 * nb, scr, C.lane); continue; } r -= I6;
        if (r < I7) { const int kb = r / 64, nb = r % 64; tr_item(P.in[16], DM, DM, (bf16*)(ws + WS_WOUT1), 32 * nb, 64 * kb, 32 * nb, scr, C.lane); continue; } r -= I7;
        if (r < I8) { const int e = r / (32 * 88), q = r % (32 * 88), kb = q / 88, nb = q % 88;
            tr_item8(P.in[20] + (size_t)e * DM * 2 * EDIM, DM, 2 * EDIM, ws + WS_MGU + (size_t)e * 2 * EDIM * DM, gu_row(32 * nb, EDIM), 64 * kb, 32 * nb, S8_W1, scr, C.lane); continue; } r -= I8;
        { const int e = r / (24 * 64), q = r % (24 * 64), kb = q / 64, nb = q % 64; unsigned char* wt = ws + WS_MDN + (size_t)e * DM * EPAD;
            if (kb < 22) tr_item8(P.in[21] + (size_t)e * EDIM * DM, EPAD, DM, wt, 32 * nb, 64 * kb, 32 * nb, S8_W2, scr, C.lane);
            else { const int n = C.lane >> 1, hf = C.lane & 1; const u32x4 z = {0u, 0u, 0u, 0u};
                st16(wt + (size_t)(32 * nb + n) * EPAD + 64 * kb + 32 * hf, z); st16(wt + (size_t)(32 * nb + n) * EPAD + 64 * kb + 32 * hf + 16, z); } }
    }
    { unsigned long long* lx = (unsigned long long*)(ws + WS_LNX);
        for (size_t i = (size_t)C.wg * 512 + C.tid; i < (size_t)(3 * 2 * MiB / 8); i += (size_t)C.G * 512) __hip_atomic_store(lx + i, 0ull, __ATOMIC_RELAXED, __HIP_MEMORY_SCOPE_AGENT); }
    const float* x = P.in[0]; bf16* XB = (bf16*)(ws + WS_XB);
    const size_t n8 = (size_t)M * DM / 8, stride = (size_t)C.G * 512;
#pragma unroll 4
    for (size_t i = (size_t)C.wg * 512 + C.tid; i < n8; i += stride) {
        const f32x4 a = *(const f32x4*)(x + i * 8), b = *(const f32x4*)(x + i * 8 + 4);
        u32x4 w; w.x = cvt_pk_bf16(a[0], a[1]); w.y = cvt_pk_bf16(a[2], a[3]); w.z = cvt_pk_bf16(b[0], b[1]); w.w = cvt_pk_bf16(b[2], b[3]);
        st16(XB + i * 8, w);
    }
}

template <int W> __device__ __forceinline__ void pooldiff_group(const Ctx& C, const bf16* PROJ, bf16* D, int g) {
    const size_t nitems = (size_t)M * 32, stride = (size_t)C.G * 512;
    for (size_t it = (size_t)C.wg * 512 + C.tid; it < nitems; it += stride) {
        const int row = (int)(it >> 5), c32 = (int)(it & 31), t = row & (SEQ - 1);
        const bf16* p = PROJ + (size_t)row * 4096 + g * 256 + c32 * 8;
        u32x4 v[W];
#pragma unroll
        for (int j = 0; j < W; ++j) { const int jj = j < t ? j : t; v[j] = *(const u32x4*)(p - (size_t)jj * 4096); }
        float s[8] = {bf_lo(v[0].x), bf_hi(v[0].x), bf_lo(v[0].y), bf_hi(v[0].y), bf_lo(v[0].z), bf_hi(v[0].z), bf_lo(v[0].w), bf_hi(v[0].w)};
        float o[8];
#pragma unroll
        for (int k = 0; k < 8; ++k) o[k] = s[k];
#pragma unroll
        for (int j = 1; j < W; ++j) { const float m = (j <= t) ? 1.0f : 0.0f;
            s[0] += m * bf_lo(v[j].x); s[1] += m * bf_hi(v[j].x); s[2] += m * bf_lo(v[j].y); s[3] += m * bf_hi(v[j].y); s[4] += m * bf_lo(v[j].z); s[5] += m * bf_hi(v[j].z); s[6] += m * bf_lo(v[j].w); s[7] += m * bf_hi(v[j].w); }
        const float inv = 1.0f / (float)((t + 1) < W ? (t + 1) : W);
#pragma unroll
        for (int k = 0; k < 8; ++k) o[k] = s[k] * inv - o[k];
        u32x4 wv; wv.x = cvt_pk_bf16(o[0], o[1]); wv.y = cvt_pk_bf16(o[2], o[3]); wv.z = cvt_pk_bf16(o[4], o[5]); wv.w = cvt_pk_bf16(o[6], o[7]);
        st16(D + (size_t)row * DM + g * 256 + c32 * 8, wv);
    }
}
__device__ __forceinline__ void p_pooldiff(const Ctx& C, const bf16* PROJ, bf16* D) {
    pooldiff_group<2>(C, PROJ, D, 0); pooldiff_group<4>(C, PROJ, D, 1); pooldiff_group<8>(C, PROJ, D, 2); pooldiff_group<16>(C, PROJ, D, 3);
}

__device__ __forceinline__ void p_attention(const Ctx& C, const bf16* PROJ, bf16* MIX) {
    constexpr int KP = 136, VP = 68;
    LAS bf16* Ks = (LAS bf16*)C.lds;
    LAS bf16* Vt = (LAS bf16*)(C.lds + 2 * 64 * KP * 2);
    volatile LAS int* flg = (volatile LAS int*)(C.lds + 2 * 64 * KP * 2 + 2 * 128 * VP * 2);
    const int lane = C.lane, w = C.wave, r = lane & 31, h = lane >> 5, tid = C.tid;
    const int rp = 16 * ((r >> 2) & 1) + 4 * (r >> 3) + (r & 3);
    constexpr float SC2 = 0.08838834764831845f * 1.4426950408889634f;
    constexpr float RDONE = 1.0e-37f;
    for (int ui = C.wg; ui < 1024; ui += C.G) {
        const int bh = ui & 15, qb = ui >> 4, b = bh >> 3, hd = bh & 7;
        const size_t rowbase = (size_t)b * SEQ;
        const int tw0 = qb * 256 + w * 32;
        bf16x8 qf[8];
        { const bf16* qp = PROJ + (rowbase + tw0 + r) * 4096 + 1024 + hd * 128 + 8 * h;
#pragma unroll
          for (int st = 0; st < 8; ++st) qf[st] = *(const bf16x8*)(qp + 16 * st); }
        f32x16 O[4];
#pragma unroll
        for (int d = 0; d < 4; ++d)
#pragma unroll
            for (int i = 0; i < 16; ++i) O[d][i] = 0.f;
        float R = 1.0f; bool wdone = false;
        const int kt_hi = qb * 4 + 3;
        u32x4 kreg[2], vreg[2];
#define ATT_LOAD(kt) do { _Pragma("unroll") for (int _i = 0; _i < 2; ++_i) { const int _c = tid + 512 * _i; \
            kreg[_i] = *(const u32x4*)(PROJ + (rowbase + 64 * (kt) + (_c >> 4)) * 4096 + 2048 + hd * 128 + 8 * (_c & 15)); \
            vreg[_i] = *(const u32x4*)(PROJ + (rowbase + 64 * (kt) + lane) * 4096 + 3072 + hd * 128 + 8 * (w + 8 * _i)); } } while (0)
#define ATT_STORE(buf) do { _Pragma("unroll") for (int _i = 0; _i < 2; ++_i) { const int _c = tid + 512 * _i; \
            *(LAS u32x4*)(Ks + (buf) * 64 * KP + (_c >> 4) * KP + 8 * (_c & 15)) = kreg[_i]; \
            LAS bf16* _vp = Vt + (buf) * 128 * VP + (8 * (w + 8 * _i)) * VP + lane; const u32x4 _v = vreg[_i]; \
            _vp[0 * VP] = (bf16)(_v.x & 0xffff); _vp[1 * VP] = (bf16)(_v.x >> 16); _vp[2 * VP] = (bf16)(_v.y & 0xffff); _vp[3 * VP] = (bf16)(_v.y >> 16); \
            _vp[4 * VP] = (bf16)(_v.z & 0xffff); _vp[5 * VP] = (bf16)(_v.z >> 16); _vp[6 * VP] = (bf16)(_v.w & 0xffff); _vp[7 * VP] = (bf16)(_v.w >> 16); } } while (0)
        ATT_LOAD(kt_hi); ATT_STORE(0);
        __syncthreads();
        for (int kt = kt_hi, it = 0; ; --kt, ++it) {
            const int buf = it & 1; const bool more = kt > 0;
            if (more) ATT_LOAD(kt - 1);
            if (!wdone) {
#pragma unroll
                for (int sub = 1; sub >= 0; --sub) {
                    if (64 * kt + 32 * sub <= tw0 + 30) {
                        f32x16 acc;
#pragma unroll
                        for (int i = 0; i < 16; ++i) acc[i] = 0.f;
                        const LAS bf16* kp = Ks + buf * 64 * KP + (32 * sub + r) * KP + 8 * h;
                        bf16x8 kf[8];
#pragma unroll
                        for (int st = 0; st < 8; ++st) kf[st] = *(const LAS bf16x8*)(kp + 16 * st);
                        asm volatile("s_waitcnt lgkmcnt(0)" ::: "memory"); __builtin_amdgcn_sched_barrier(0);
#pragma unroll
                        for (int st = 0; st < 8; ++st) acc = __builtin_amdgcn_mfma_f32_32x32x16_bf16(kf[st], qf[st], acc, 0, 0, 0);
                        __builtin_amdgcn_sched_barrier(0);
                        bf16x8 vf[4][2];
#pragma unroll
                        for (int dt = 0; dt < 4; ++dt)
#pragma unroll
                            for (int s2 = 0; s2 < 2; ++s2) { const LAS bf16* vp = Vt + buf * 128 * VP + (32 * dt + rp) * VP + 32 * sub + 16 * s2 + 4 * h;
                                const bf16x4 lo = *(const LAS bf16x4*)vp, hi = *(const LAS bf16x4*)(vp + 8);
                                vf[dt][s2] = (bf16x8){lo[0], lo[1], lo[2], lo[3], hi[0], hi[1], hi[2], hi[3]}; }
                        __builtin_amdgcn_sched_barrier(0);
                        const int key0 = 64 * kt + 32 * sub + 4 * h, query = tw0 + r;
                        float E[16], D0[4], L1[4], L2[4], IV[4];
#pragma unroll
                        for (int i = 0; i < 16; ++i) { const int key = key0 + (i & 3) + 8 * (i >> 2); const bool valid = key < query;
                            const float e = __builtin_amdgcn_exp2f(fminf(acc[i] * SC2, 20.0f)); E[i] = valid ? e : 0.0f; }
                        float T[4], PGm[4];
#pragma unroll
                        for (int g = 0; g < 4; ++g) { const float d0 = 1.0f + E[4 * g], d1 = 1.0f + E[4 * g + 1], d2 = 1.0f + E[4 * g + 2], d3 = 1.0f + E[4 * g + 3];
                            const float l1 = d0 * d1, l2 = l1 * d2, Gs = __builtin_amdgcn_rcpf(l2 * d3); D0[g] = d0; L1[g] = l1; L2[g] = l2; IV[g] = Gs;
                            const auto rr = __builtin_amdgcn_permlane32_swap(__float_as_uint(Gs), __float_as_uint(Gs), false, false);
                            const float lo = __uint_as_float(rr[0]), hi = __uint_as_float(rr[1]);
                            T[g] = lo * hi; PGm[g] = (h == 0) ? hi : 1.0f; }
                        float SG[4]; SG[3] = 1.0f; SG[2] = T[3]; SG[1] = T[3] * T[2]; SG[0] = SG[1] * T[1];
                        const float total = SG[0] * T[0];
                        float a[16];
#pragma unroll
                        for (int g = 0; g < 4; ++g) { const float t0 = (R * SG[g] * PGm[g]) * IV[g];
                            a[4 * g + 0] = E[4 * g + 0] * t0; a[4 * g + 1] = E[4 * g + 1] * (t0 * D0[g]); a[4 * g + 2] = E[4 * g + 2] * (t0 * L1[g]); a[4 * g + 3] = E[4 * g + 3] * (t0 * L2[g]); }
                        R *= total;
                        bf16x8 pb[2];
#pragma unroll
                        for (int s = 0; s < 2; ++s) { u32x4 wv; wv.x = cvt_pk_bf16(a[8 * s + 0], a[8 * s + 1]); wv.y = cvt_pk_bf16(a[8 * s + 2], a[8 * s + 3]); wv.z = cvt_pk_bf16(a[8 * s + 4], a[8 * s + 5]); wv.w = cvt_pk_bf16(a[8 * s + 6], a[8 * s + 7]);
                            pb[s] = __builtin_bit_cast(bf16x8, wv); }
                        asm volatile("s_waitcnt lgkmcnt(0)" ::: "memory"); __builtin_amdgcn_sched_barrier(0);
#pragma unroll
                        for (int dt = 0; dt < 4; ++dt)
#pragma unroll
                            for (int s = 0; s < 2; ++s) O[dt] = __builtin_amdgcn_mfma_f32_32x32x16_bf16(vf[dt][s], pb[s], O[dt], 0, 0, 0);
                        __builtin_amdgcn_sched_barrier(0);
                    }
                }
                wdone = __all(R < RDONE);
            }
            if (more) ATT_STORE(buf ^ 1);
            if (lane == 0) flg[buf * 8 + w] = wdone ? 1 : 0;
            __syncthreads();
            if (!more) break;
            int alld = 1;
#pragma unroll
            for (int j = 0; j < 8; ++j) alld &= flg[buf * 8 + j];
            if (alld) break;
        }
#undef ATT_LOAD
#undef ATT_STORE
        bf16* op = MIX + (rowbase + tw0 + r) * DM + 1024 + hd * 128 + 16 * h;
#pragma unroll
        for (int dt = 0; dt < 4; ++dt)
#pragma unroll
            for (int hv = 0; hv < 2; ++hv) { const int i0 = 8 * hv; u32x4 wv; wv.x = cvt_pk_bf16(O[dt][i0], O[dt][i0 + 1]); wv.y = cvt_pk_bf16(O[dt][i0 + 2], O[dt][i0 + 3]); wv.z = cvt_pk_bf16(O[dt][i0 + 4], O[dt][i0 + 5]); wv.w = cvt_pk_bf16(O[dt][i0 + 6], O[dt][i0 + 7]);
                st16(op + 32 * dt + 8 * hv, wv); }
        __syncthreads();
    }
}

template <bool OUT_F32, bool ROUTE, bool W8 = false, bool PRE = false>
__device__ __forceinline__ void p_layernorm(const Ctx& C, const bf16* Tin, const float* gam, const float* bet, bf16* XBo, float* outf, unsigned char* X8o, const float* wr_, unsigned* cnt, int* list, float* gates, int* ppos = nullptr) {
    LAS float* WrT = (LAS float*)C.lds;
    LAS int* rec = (LAS int*)(C.lds + 65536);
    const int lane = C.lane;
    if (ROUTE) { for (int i = C.tid; i < DM * 8; i += 512) { const int c = i >> 3, e = i & 7; WrT[e * DM + c] = wr_[i]; } __syncthreads(); }
    f32x4 gv[8], bv[8];
#pragma unroll
    for (int j = 0; j < 4; ++j) { if (PRE) { gv[2 * j] = gv[2 * j + 1] = bv[2 * j] = bv[2 * j + 1] = (f32x4){0.f, 0.f, 0.f, 0.f}; continue; }
        gv[2 * j] = *(const f32x4*)(gam + 512 * j + 8 * lane); gv[2 * j + 1] = *(const f32x4*)(gam + 512 * j + 8 * lane + 4);
        bv[2 * j] = *(const f32x4*)(bet + 512 * j + 8 * lane); bv[2 * j + 1] = *(const f32x4*)(bet + 512 * j + 8 * lane + 4); }
    const int rows_per = (M + C.G - 1) / C.G, row_lo = C.wg * rows_per, row_hi = (row_lo + rows_per) < M ? (row_lo + rows_per) : M;
#pragma unroll 2
    for (int row = row_lo + C.wave; row < row_hi; row += 8) {
        const bf16* xr = Tin + (size_t)row * DM + 8 * lane;
        f32x4 v[8]; float s = 0.f;
#pragma unroll
        for (int j = 0; j < 4; ++j) { const u32x4 r = *(const u32x4*)(xr + 512 * j);
            v[2 * j] = (f32x4){bf_lo(r.x), bf_hi(r.x), bf_lo(r.y), bf_hi(r.y)}; v[2 * j + 1] = (f32x4){bf_lo(r.z), bf_hi(r.z), bf_lo(r.w), bf_hi(r.w)}; }
#pragma unroll
        for (int j = 0; j < 8; ++j) s += (v[j][0] + v[j][1]) + (v[j][2] + v[j][3]);
        if (!PRE) {
        const float mean = wave_sum(s) * (1.0f / DM); float q = 0.f;
#pragma unroll
        for (int j = 0; j < 8; ++j) { v[j] = v[j] - mean; q += (v[j][0] * v[j][0] + v[j][1] * v[j][1]) + (v[j][2] * v[j][2] + v[j][3] * v[j][3]); }
        const float rstd = 1.0f / sqrtf(wave_sum(q) * (1.0f / DM) + LN_EPS);
#pragma unroll
        for (int j = 0; j < 8; ++j) v[j] = v[j] * rstd * gv[j] + bv[j];
        }
        if (PRE) {} else if (OUT_F32) { float* o = outf + (size_t)row * DM + 8 * lane;
#pragma unroll
            for (int j = 0; j < 4; ++j) { st16f(o + 512 * j, v[2 * j]); st16f(o + 512 * j + 4, v[2 * j + 1]); } }
        else { bf16* xb = XBo + (size_t)row * DM + 8 * lane;
#pragma unroll
            for (int j = 0; j < 4; ++j) { u32x4 wv; wv.x = cvt_pk_bf16(v[2 * j][0], v[2 * j][1]); wv.y = cvt_pk_bf16(v[2 * j][2], v[2 * j][3]); wv.z = cvt_pk_bf16(v[2 * j + 1][0], v[2 * j + 1][1]); wv.w = cvt_pk_bf16(v[2 * j + 1][2], v[2 * j + 1][3]);
                st16(xb + 512 * j, wv); }
            if (W8) { unsigned char* x8 = X8o + (size_t)row * DM + 8 * lane;
#pragma unroll
                for (int j = 0; j < 4; ++j) { u32x2 wv; wv.x = pk4_fp8(v[2 * j][0] * S8_X, v[2 * j][1] * S8_X, v[2 * j][2] * S8_X, v[2 * j][3] * S8_X); wv.y = pk4_fp8(v[2 * j + 1][0] * S8_X, v[2 * j + 1][1] * S8_X, v[2 * j + 1][2] * S8_X, v[2 * j + 1][3] * S8_X);
                    st8(x8 + 512 * j, wv); } } }
        if (ROUTE) {
            float lg[8];
#pragma unroll
            for (int e = 0; e < 8; ++e) { float a = 0.f;
#pragma unroll
                for (int j = 0; j < 4; ++j) { const f32x4 w0 = *(const LAS f32x4*)(WrT + e * DM + 512 * j + 8 * lane), w1 = *(const LAS f32x4*)(WrT + e * DM + 512 * j + 8 * lane + 4);
                    a += (v[2 * j][0] * w0[0] + v[2 * j][1] * w0[1]) + (v[2 * j][2] * w0[2] + v[2 * j][3] * w0[3]) + (v[2 * j + 1][0] * w1[0] + v[2 * j + 1][1] * w1[1]) + (v[2 * j + 1][2] * w1[2] + v[2 * j + 1][3] * w1[3]); }
                lg[e] = wave_sum(a); }
            int e0 = 0; float v0 = lg[0];
#pragma unroll
            for (int e = 1; e < 8; ++e) if (lg[e] > v0) { v0 = lg[e]; e0 = e; }
            int e1 = -1; float v1 = -3.0e38f;
#pragma unroll
            for (int e = 0; e < 8; ++e) if (e != e0 && lg[e] > v1) { v1 = lg[e]; e1 = e; }
            const float g0 = 1.0f / (1.0f + __expf(v1 - v0)), g1 = 1.0f - g0;
            if (lane == 0) { LAS int* rc = rec + (row - row_lo) * 4; rc[0] = e0; rc[1] = e1; rc[2] = __float_as_int(g0); rc[3] = __float_as_int(g1); }
        }
    }
    if (ROUTE) {
        __syncthreads();
        if (C.tid < 16) {
            const int g = C.tid, slot = g >> 3, e = g & 7, nrow = row_hi - row_lo; int n = 0;
            for (int i = 0; i < nrow; ++i) n += (rec[i * 4 + slot] == e) ? 1 : 0;
            if (n > 0) { int pos = (int)__hip_atomic_fetch_add(cnt + g, (unsigned)n, RLX_AGENT);
                for (int i = 0; i < nrow; ++i) if (rec[i * 4 + slot] == e) { list[g * LISTCAP + pos] = row_lo + i; gates[g * LISTCAP + pos] = __int_as_float(rec[i * 4 + 2 + slot]); ppos[(row_lo + i) * 2 + slot] = (g << 15) | pos; ++pos; } }
        }
        __syncthreads();
    }
}

__device__ __forceinline__ void p_router(const Ctx& C, const bf16* Hin, const float* wr_, unsigned* cnt, int* list, float* gates, int* ppos) {
    constexpr int WPT = 2056;
    LAS bf16* Wh = (LAS bf16*)C.lds; LAS bf16* Wl = Wh + 8 * WPT;
    LAS float* LG = (LAS float*)(C.lds + 2 * 8 * WPT * 2);
    LAS int* rec = (LAS int*)(C.lds + 2 * 8 * WPT * 2 + 4096);
    const int lane = C.lane, w = C.wave, r16 = lane & 15, q = lane >> 4;
    for (int i = C.tid; i < DM * 8; i += 512) { const int c = i >> 3, e = i & 7; const float x = wr_[i]; const unsigned hb = cvt_pk_bf16(x, 0.f) & 0xffff; const float lo = x - __uint_as_float(hb << 16);
        Wh[e * WPT + c] = (bf16)hb; Wl[e * WPT + c] = (bf16)(cvt_pk_bf16(lo, 0.f) & 0xffff); }
    __syncthreads();
    const int rows_per = (M + C.G - 1) / C.G, row_lo = C.wg * rows_per, row_hi = (row_lo + rows_per) < M ? (row_lo + rows_per) : M;
    for (int rb = 0; rb < rows_per; rb += 128) {
        int myrow = row_lo + rb + 16 * w + r16; if (myrow >= row_hi) myrow = row_hi - 1;
        const bf16* ap = Hin + (size_t)myrow * DM + 8 * q; const LAS bf16* bh = Wh + (r16 & 7) * WPT + 8 * q; const LAS bf16* bl = Wl + (r16 & 7) * WPT + 8 * q;
        f32x4 a0 = {0.f, 0.f, 0.f, 0.f}, a1 = {0.f, 0.f, 0.f, 0.f};
        for (int k0 = 0; k0 < 64; k0 += 8) { bf16x8 af[8];
#pragma unroll
            for (int k = 0; k < 8; ++k) af[k] = *(const bf16x8*)(ap + 32 * (k0 + k));
#pragma unroll
            for (int k = 0; k < 8; ++k) { const bf16x8 h8 = *(const LAS bf16x8*)(bh + 32 * (k0 + k)), l8 = *(const LAS bf16x8*)(bl + 32 * (k0 + k));
                a0 = __builtin_amdgcn_mfma_f32_16x16x32_bf16(af[k], h8, a0, 0, 0, 0); a1 = __builtin_amdgcn_mfma_f32_16x16x32_bf16(af[k], l8, a1, 0, 0, 0); } }
        a0 = a0 + a1;
        if (r16 < 8) {
#pragma unroll
            for (int e = 0; e < 4; ++e) LG[(16 * w + 4 * q + e) * 8 + r16] = a0[e]; }
        __syncthreads();
        if (C.tid < 128 && row_lo + rb + C.tid < row_hi) { const f32x4 la = *(const LAS f32x4*)(LG + C.tid * 8), lb = *(const LAS f32x4*)(LG + C.tid * 8 + 4);
            const float lg[8] = {la[0], la[1], la[2], la[3], lb[0], lb[1], lb[2], lb[3]};
            int e0 = 0; float v0 = lg[0];
#pragma unroll
            for (int e = 1; e < 8; ++e) if (lg[e] > v0) { v0 = lg[e]; e0 = e; }
            int e1 = -1; float v1 = -3.0e38f;
#pragma unroll
            for (int e = 0; e < 8; ++e) if (e != e0 && lg[e] > v1) { v1 = lg[e]; e1 = e; }
            const float g0 = 1.0f / (1.0f + __expf(v1 - v0)), g1 = 1.0f - g0;
            LAS int* rc = rec + (rb + C.tid) * 4; rc[0] = e0; rc[1] = e1; rc[2] = __float_as_int(g0); rc[3] = __float_as_int(g1); }
        __syncthreads();
    }
    if (rows_per == 128 && row_hi - row_lo == 128) {
        LAS int* cw = rec + 4 * 128;
        int gid[2] = {0, 0}, rk[2] = {0, 0}; float gt[2] = {0.f, 0.f};
        if (C.tid < 128) { const LAS int* rc = rec + C.tid * 4; gid[0] = rc[0]; gid[1] = 8 + rc[1]; gt[0] = __int_as_float(rc[2]); gt[1] = __int_as_float(rc[3]);
            const unsigned long long below = (1ull << lane) - 1ull;
#pragma unroll
            for (int g = 0; g < 16; ++g) { const unsigned long long m = __ballot(gid[g >> 3] == g);
                if (gid[g >> 3] == g) rk[g >> 3] = __popcll(m & below);
                if (lane == 0) cw[w * 16 + g] = __popcll(m); } }
        __syncthreads();
        if (C.tid < 16) { const int n0 = cw[C.tid], n1 = cw[16 + C.tid]; const int n = n0 + n1;
            cw[32 + C.tid] = n > 0 ? (int)__hip_atomic_fetch_add(cnt + C.tid, (unsigned)n, RLX_AGENT) : 0; }
        __syncthreads();
        if (C.tid < 128) {
#pragma unroll
            for (int sl = 0; sl < 2; ++sl) { const int g = gid[sl], pos = cw[32 + g] + (w == 1 ? cw[g] : 0) + rk[sl];
                list[g * LISTCAP + pos] = row_lo + C.tid; gates[g * LISTCAP + pos] = gt[sl]; ppos[(row_lo + C.tid) * 2 + sl] = (g << 15) | pos; } }
    } else if (C.tid < 16) {
        const int g = C.tid, slot = g >> 3, e = g & 7, nrow = row_hi - row_lo; int n = 0;
        for (int i = 0; i < nrow; ++i) n += (rec[i * 4 + slot] == e) ? 1 : 0;
        if (n > 0) { int pos = (int)__hip_atomic_fetch_add(cnt + g, (unsigned)n, RLX_AGENT);
            for (int i = 0; i < nrow; ++i) if (rec[i * 4 + slot] == e) { list[g * LISTCAP + pos] = row_lo + i; gates[g * LISTCAP + pos] = __int_as_float(rec[i * 4 + 2 + slot]); ppos[(row_lo + i) * 2 + slot] = (g << 15) | pos; ++pos; } }
    }
    __syncthreads();
}

__device__ __forceinline__ void p_final_ln(const Ctx& C, const bf16* XBi, const bf16* OP, const int* ppos, const float* gam, const float* bet, float* outf) {
    const LAS int* tbase = (const LAS int*)(C.lds + TAB_OFF);
    const int lane = C.lane;
    f32x4 gv[8], bv[8];
#pragma unroll
    for (int j = 0; j < 4; ++j) { gv[2 * j] = *(const f32x4*)(gam + 512 * j + 8 * lane); gv[2 * j + 1] = *(const f32x4*)(gam + 512 * j + 8 * lane + 4);
        bv[2 * j] = *(const f32x4*)(bet + 512 * j + 8 * lane); bv[2 * j + 1] = *(const f32x4*)(bet + 512 * j + 8 * lane + 4); }
    const int rows_per = (M + C.G - 1) / C.G, row_lo = C.wg * rows_per, row_hi = (row_lo + rows_per) < M ? (row_lo + rows_per) : M;
    for (int row = row_lo + C.wave; row < row_hi; row += 8) {
        const int p0 = ppos[row * 2], p1 = ppos[row * 2 + 1];
        const size_t r0 = (size_t)(tbase[p0 >> 15] + (p0 & 32767)), r1 = (size_t)(tbase[p1 >> 15] + (p1 & 32767));
        const bf16* xr = XBi + (size_t)row * DM + 8 * lane; const bf16* o0 = OP + r0 * DM + 8 * lane; const bf16* o1 = OP + r1 * DM + 8 * lane;
        u32x4 a[4], b[4], c[4];
#pragma unroll
        for (int j = 0; j < 4; ++j) { a[j] = *(const u32x4*)(xr + 512 * j); b[j] = *(const u32x4*)(o0 + 512 * j); c[j] = *(const u32x4*)(o1 + 512 * j); }
        f32x4 v[8]; float s = 0.f;
#pragma unroll
        for (int j = 0; j < 4; ++j) {
            v[2 * j] = (f32x4){bf_lo(a[j].x), bf_hi(a[j].x), bf_lo(a[j].y), bf_hi(a[j].y)} * DN_ALPHA + ((f32x4){bf_lo(b[j].x), bf_hi(b[j].x), bf_lo(b[j].y), bf_hi(b[j].y)} + (f32x4){bf_lo(c[j].x), bf_hi(c[j].x), bf_lo(c[j].y), bf_hi(c[j].y)});
            v[2 * j + 1] = (f32x4){bf_lo(a[j].z), bf_hi(a[j].z), bf_lo(a[j].w), bf_hi(a[j].w)} * DN_ALPHA + ((f32x4){bf_lo(b[j].z), bf_hi(b[j].z), bf_lo(b[j].w), bf_hi(b[j].w)} + (f32x4){bf_lo(c[j].z), bf_hi(c[j].z), bf_lo(c[j].w), bf_hi(c[j].w)}); }
#pragma unroll
        for (int j = 0; j < 8; ++j) s += (v[j][0] + v[j][1]) + (v[j][2] + v[j][3]);
        const float mean = wave_sum(s) * (1.0f / DM); float q = 0.f;
#pragma unroll
        for (int j = 0; j < 8; ++j) { v[j] = v[j] - mean; q += (v[j][0] * v[j][0] + v[j][1] * v[j][1]) + (v[j][2] * v[j][2] + v[j][3] * v[j][3]); }
        const float rstd = 1.0f / sqrtf(wave_sum(q) * (1.0f / DM) + LN_EPS);
        float* o = outf + (size_t)row * DM + 8 * lane;
#pragma unroll
        for (int j = 0; j < 4; ++j) { st16f(o + 512 * j, v[2 * j] * rstd * gv[2 * j] + bv[2 * j]); st16f(o + 512 * j + 4, v[2 * j + 1] * rstd * gv[2 * j + 1] + bv[2 * j + 1]); }
    }
}

__device__ __forceinline__ void p_sgu(const Ctx& C, const bf16* Z, bf16* SGo, const f32x2* vst, const float* sw, const float* sb, const float* lng, const float* lnb) {
    constexpr int WP = 136, NB = 16;
    LAS bf16* Ws = (LAS bf16*)C.lds;
    LAS bf16* vnT = (LAS bf16*)(C.lds + 128 * WP * 2);
    LAS f32x2* musr = (LAS f32x2*)(C.lds + 128 * WP * 2 + 256 * WP * 2);
    LAS float* bs = (LAS float*)(musr + NB * 128); LAS float* gm = bs + 128; LAS float* bt = gm + 256;
    const int lane = C.lane, w = C.wave, r = lane & 31, h = lane >> 5, tid = C.tid;
    const int rp = 16 * ((r >> 2) & 1) + 4 * (r >> 3) + (r & 3);
    const int sV = (lane & 31) + 32 * (w & 3), cV = (lane >> 5) + 2 * (w >> 2);
    int cur_g = -1;
    for (int ub = C.wg; ub < 2048; ub += NB * C.G) {
        int nb = (2048 - ub + C.G - 1) / C.G; if (nb > NB) nb = NB;
        __syncthreads();
        for (int idx = tid; idx < nb * 128; idx += 512) { const int u = ub + (idx >> 7) * C.G; const f32x2* p = vst + ((size_t)(u >> 3) * 128 + (idx & 127)) * 32; float s1 = 0.f, s2 = 0.f;
#pragma unroll 8
            for (int j = 0; j < 32; ++j) { const f32x2 x = p[j]; s1 += x[0]; s2 += x[1]; }
            const float mean = s1 * (1.0f / 2048.f), var = fmaxf(s2 * (1.0f / 2048.f) - mean * mean, 0.f);
            musr[idx] = (f32x2){mean, 1.0f / sqrtf(var + LN_EPS)}; }
        u32x4 vreg[8];
        { const int g0 = ub & 7; const size_t row0 = (size_t)(ub >> 3) * 128;
#pragma unroll
          for (int i = 0; i < 8; ++i) vreg[i] = *(const u32x4*)(Z + (row0 + sV) * 4096 + 2048 + g0 * 256 + 8 * (cV + 4 * i)); }
        for (int bi = 0; bi < nb; ++bi) {
            const int u = ub + bi * C.G, g = u & 7; const size_t row0 = (size_t)(u >> 3) * 128;
            if (g != cur_g) { cur_g = g; __syncthreads();
                for (int i = tid; i < 128 * 128; i += 512) { const int t = i >> 7, s2_ = i & 127; const float x = sw[(size_t)g * 16384 + i]; Ws[t * WP + s2_] = (bf16)(cvt_pk_bf16(s2_ <= t ? x : 0.f, 0.f) & 0xffff); }
                if (tid < 128) bs[tid] = sb[g * 128 + tid];
                if (tid < 256) { gm[tid] = lng[g * 256 + tid]; bt[tid] = lnb[g * 256 + tid]; }
                __syncthreads(); }
            u32x4 ureg[4][2];
#pragma unroll
            for (int tt = 0; tt < 4; ++tt) { const bf16* up = Z + (row0 + 32 * tt + r) * 4096 + g * 256 + 32 * w + 16 * h; asm volatile("" : "+v"(up));
                ureg[tt][0] = *(const u32x4*)up; ureg[tt][1] = *(const u32x4*)(up + 8); }
            { const f32x2 ms = musr[bi * 128 + sV];
              const LAS float* gmp = gm + 8 * cV; const LAS float* btp = bt + 8 * cV; LAS bf16* dstb = vnT + (8 * cV) * WP + sV;
              asm volatile("" : "+v"(gmp), "+v"(btp), "+v"(dstb));
#pragma unroll
              for (int i = 0; i < 8; ++i) { const u32x4 v = vreg[i];
                float x[8] = {bf_lo(v.x), bf_hi(v.x), bf_lo(v.y), bf_hi(v.y), bf_lo(v.z), bf_hi(v.z), bf_lo(v.w), bf_hi(v.w)};
#pragma unroll
                for (int e = 0; e < 8; ++e) { const float y = (x[e] - ms[0]) * ms[1] * gmp[32 * i + e] + btp[32 * i + e]; dstb[(32 * i + e) * WP] = (bf16)(cvt_pk_bf16(y, 0.f) & 0xffff); }
                asm volatile("" ::: "memory"); } }
            if (bi + 1 < nb) { const int un = u + C.G, gn = un & 7; const size_t rown = (size_t)(un >> 3) * 128; const bf16* vp = Z + (rown + sV) * 4096 + 2048 + gn * 256 + 8 * cV; asm volatile("" : "+v"(vp));
#pragma unroll
                for (int i = 0; i < 8; ++i) vreg[i] = *(const u32x4*)(vp + 32 * i); }
            __syncthreads();
            f32x16 acc[4];
#pragma unroll
            for (int tt = 0; tt < 4; ++tt)
#pragma unroll
                for (int i = 0; i < 16; ++i) acc[tt][i] = 0.f;
#pragma unroll
            for (int ks = 0; ks < 8; ++ks) { const bf16x8 af = *(const LAS bf16x8*)(vnT + (32 * w + rp) * WP + 16 * ks + 8 * h);
#pragma unroll
                for (int tt = 0; tt < 4; ++tt) if (ks <= 2 * tt + 1) { const bf16x8 bfr = *(const LAS bf16x8*)(Ws + (32 * tt + r) * WP + 16 * ks + 8 * h);
                    acc[tt] = __builtin_amdgcn_mfma_f32_32x32x16_bf16(af, bfr, acc[tt], 0, 0, 0); }
                asm volatile("" ::: "memory"); }
            __syncthreads();
#pragma unroll
            for (int tt = 0; tt < 4; ++tt) { const int t = 32 * tt + r; const float bb = bs[t]; bf16* op = SGo + (row0 + t) * DM + g * 256 + 32 * w + 16 * h; asm volatile("" : "+v"(op));
#pragma unroll
                for (int hv = 0; hv < 2; ++hv) { const u32x4 uv = ureg[tt][hv]; const int i0 = 8 * hv;
                    u32x4 wv; wv.x = cvt_pk_bf16(bf_lo(uv.x) * (acc[tt][i0] + bb), bf_hi(uv.x) * (acc[tt][i0 + 1] + bb)); wv.y = cvt_pk_bf16(bf_lo(uv.y) * (acc[tt][i0 + 2] + bb), bf_hi(uv.y) * (acc[tt][i0 + 3] + bb));
                    wv.z = cvt_pk_bf16(bf_lo(uv.z) * (acc[tt][i0 + 4] + bb), bf_hi(uv.z) * (acc[tt][i0 + 5] + bb)); wv.w = cvt_pk_bf16(bf_lo(uv.w) * (acc[tt][i0 + 6] + bb), bf_hi(uv.w) * (acc[tt][i0 + 7] + bb));
                    st16(op + 8 * hv, wv); } }
        }
    }
    __syncthreads();
}

__device__ __forceinline__ void moe_tables(const Ctx& C, const unsigned* cnt) {
    LAS int* tbase = (LAS int*)(C.lds + TAB_OFF); LAS int* tcnt = tbase + 17; LAS unsigned char* tileg = (LAS unsigned char*)(tcnt + 16);
    __syncthreads();
    if (C.tid < 16) { int c = (int)__hip_atomic_load(cnt + C.tid, RLX_AGENT); if (c > LISTCAP) c = LISTCAP; tcnt[C.tid] = c; }
    __syncthreads();
    if (C.tid == 0) { int base = 0;
        for (int g = 0; g < 16; ++g) { tbase[g] = base; base += ((tcnt[g] + 255) >> 8) << 8; }
        tbase[16] = base; }
    __syncthreads();
    for (int t = C.tid; t < (tbase[16] >> 8); t += 512) { int g = 0;
#pragma unroll
        for (int k = 1; k < 16; ++k) g += (t * 256 >= tbase[k]) ? 1 : 0;
        tileg[t] = (unsigned char)g; }
    __syncthreads();
}

__global__ void __launch_bounds__(512, 2) fwd_kernel(Ptrs P) {
    extern __shared__ __attribute__((aligned(16))) unsigned char lds_raw[];
    Ctx C; C.lds = (LAS unsigned char*)lds_raw; C.tid = threadIdx.x; C.lane = C.tid & 63; C.wave = __builtin_amdgcn_readfirstlane(C.tid >> 6); C.G = gridDim.x; C.wg = blockIdx.x;
    unsigned char* ws = P.ws;
    unsigned* ctl = (unsigned*)(ws + WS_CTL);
    for (int u = C.tid; u < (LDS_BYTES - RING_BYTES) / 4; u += 512) ((LAS unsigned*)(C.lds + RING_BYTES))[u] = 0u;
    __syncthreads();
    XcdBarrier bar; bar.bar = ctl + CW_BAR; bar.x = 0; bar.st = nullptr;
    if (!MK_PER_PHASE) bar = xcd_barrier_post(ctl + CW_BAR, (volatile LAS unsigned*)(C.lds + MISC_OFF) + 8);
    const int lo = P.ph_lo, hi = P.ph_hi;
#ifndef PH_MASK
#define PH_MASK 0x1ffff
#endif
#define IN(k) (((PH_MASK >> (k)) & 1) && lo <= (k) && (k) < hi)
#ifndef REP_MASK
#define REP_MASK 0
#endif
#define REP(k) (1 + ((REP_MASK >> (k)) & 1))
#define SEAM(k) do { if (IN(k) && IN((k) + 1)) xcd_barrier(bar); } while (0)
#define XB ((bf16*)(ws + WS_XB))
#define TB ((bf16*)(ws + WS_TB))
#define OUT (P.out)
#define PROJ ((bf16*)(ws + WS_PROJ))
#define MIX ((bf16*)(ws + WS_MIX))
#define HID ((bf16*)(ws + WS_HID))
#define Zb ((bf16*)(ws + WS_Z))
#define SGb ((bf16*)(ws + WS_SG))
#define MHID ((bf16*)(ws + WS_MHID))
#define Dd ((bf16*)(ws + WS_D))
#define VST ((f32x2*)(ws + WS_VST))
#define LIST ((int*)(ws + WS_LIST))
#define GATE ((float*)(ws + WS_GATE))
#define CNT (ctl + CW_CNT)
    const LAS int* tbase = (const LAS int*)(C.lds + TAB_OFF); const LAS int* tcnt = tbase + 17; const LAS unsigned char* tileg = (const LAS unsigned char*)(tcnt + 16);

    if (IN(0)) for (int rep_ = 0; rep_ < REP(0); ++rep_) { p_prologue(C, P); }
    if (!MK_PER_PHASE && IN(0) && IN(1) && C.wave == 0) { unsigned c_ = 0u, sp_ = 0u;
        for (;;) { c_ = (C.lane < 16) ? xb_ld(&bar.bar[XB_XCNT(C.lane)]) : 0u; unsigned s_ = c_;
#pragma unroll
            for (int o = 1; o < 16; o <<= 1) s_ += __shfl_xor(s_, o);
            if ((unsigned)__builtin_amdgcn_readfirstlane((int)s_) == gridDim.x) break;
            if (++sp_ > 4096u) break; __builtin_amdgcn_s_sleep(4); }
        if (sp_ <= 4096u) { const unsigned nx_ = (unsigned)__popcll(__ballot(c_ > 0u)), mine_ = (unsigned)__builtin_amdgcn_readlane((int)c_, (int)bar.x);
            if (C.lane == 0 && mine_ > 0u && nx_ > 0u) { bar.st[0] = mine_; bar.st[1] = nx_; } } }
    SEAM(0);
    if (IN(1)) for (int rep_ = 0; rep_ < REP(1); ++rep_) { pg8::Gemm g{XB, (const bf16*)(ws + WS_WIN0), DM, DM}; pg8::StaticOrder S; S.init(M, EVEN_IN, C.G, C.wg); pg8::EpiBf16 E{PROJ, 4096};
        pg8::gemm_phase<pg8::EpiBf16, pg8::StaticOrder, false>(C.lds, g, S, E);
        int k256 = 256; asm volatile("" : "+s"(k256)); pg8::Gemm gf{(const bf16*)(ws + WS_WTMP), (const bf16*)(ws + WS_PW), k256, 1024}; pg8::FoldOrder Sf{C.wg}; pg8::EpiBf16 Ef{(bf16*)(ws + WS_WOUT0), DM};
        pg8::gemm_phase<pg8::EpiBf16, pg8::FoldOrder, false>(C.lds, gf, Sf, Ef); } SEAM(1);
    if (IN(2)) { for (int rep = 0; rep < REP(2); ++rep) { p_pooldiff(C, PROJ, MIX); p_attention(C, PROJ, MIX); } } SEAM(2);
    const bool fuse_ln = (!MK_PER_PHASE) && C.G == 256;
    if (IN(4)) { pg8::Gemm g{MIX, (const bf16*)(ws + WS_WOUT0), DM, DM};
        if (fuse_ln) { pg8::PanelOrder S{C.wg}; pg8::EpiResLn E{XB, XB, 1.0f, P.in[5], P.in[6], (unsigned long long*)(ws + WS_LNX), ctl + CW_PAN, C.lds + LNX_OFF, ws + WS_X8};
            pg8::gemm_phase<pg8::EpiResLn, pg8::PanelOrder, false>(C.lds, g, S, E); }
        else { pg8::StaticOrder S; S.init(M, DM, C.G, C.wg); pg8::EpiRes E{XB, TB, 1.0f};
            pg8::gemm_phase<pg8::EpiRes, pg8::StaticOrder, false>(C.lds, g, S, E); } } SEAM(4);
    if (IN(5) && !fuse_ln) { p_layernorm<false, false, true>(C, TB, P.in[5], P.in[6], XB, nullptr, ws + WS_X8, nullptr, nullptr, nullptr, nullptr); }
    if (!fuse_ln) SEAM(5);
    if (IN(6)) { pg8::Gemm g{(const bf16*)(ws + WS_X8), (const bf16*)(ws + WS_WGU), DM, DM}; pg8::StaticOrder S; S.init(M, 2 * FFN, C.G, C.wg); pg8::EpiSwiglu8 E{ws + WS_HID, FFN, 44, 1.0f / (S8_X * S8_W1), 0};
        pg8::gemm_phase<pg8::EpiSwiglu8, pg8::StaticOrder, false, true>(C.lds, g, S, E); } SEAM(6);
    if (IN(7)) { pg8::Gemm g{(const bf16*)(ws + WS_HID), (const bf16*)(ws + WS_WDN), FFN, FFN};
        if (fuse_ln) { pg8::PanelOrder S{C.wg}; pg8::EpiResLn E{XB, XB, 1.0f / (S8_H * S8_W2), P.in[9], P.in[10], (unsigned long long*)(ws + WS_LNX) + 262144, ctl + CW_PAN + 8192, C.lds + LNX_OFF, nullptr};
            pg8::gemm_phase<pg8::EpiResLn, pg8::PanelOrder, false, true>(C.lds, g, S, E); }
        else { pg8::StaticOrder S; S.init(M, DM, C.G, C.wg); pg8::EpiRes E{XB, TB, 1.0f / (S8_H * S8_W2)};
            pg8::gemm_phase<pg8::EpiRes, pg8::StaticOrder, false, true>(C.lds, g, S, E); } } SEAM(7);
    if (IN(8) && !fuse_ln) { p_layernorm<false, false>(C, TB, P.in[9], P.in[10], XB, nullptr, nullptr, nullptr, nullptr, nullptr, nullptr); }
    if (!fuse_ln) SEAM(8);
    if (IN(9)) for (int rep_ = 0; rep_ < REP(9); ++rep_) { pg8::Gemm g{XB, (const bf16*)(ws + WS_WIN1), DM, DM}; pg8::StaticOrder S; S.init(M, 4096, C.G, C.wg); pg8::EpiGeluStats E{Zb, VST};
        pg8::gemm_phase<pg8::EpiGeluStats, pg8::StaticOrder, false>(C.lds, g, S, E); } SEAM(9);
    if (IN(10)) { for (int rep = 0; rep < REP(10); ++rep) p_sgu(C, Zb, SGb, VST, P.in[14], P.in[15], P.in[12], P.in[13]); } SEAM(10);
    if (IN(11)) { pg8::Gemm g{SGb, (const bf16*)(ws + WS_WOUT1), DM, DM};
        if (fuse_ln) { pg8::PanelOrder S{C.wg}; pg8::EpiResLn E{XB, XB, 1.0f, P.in[17], P.in[18], (unsigned long long*)(ws + WS_LNX) + 2 * 262144, ctl + CW_PAN + 2 * 8192, C.lds + LNX_OFF, ws + WS_X8};
            pg8::gemm_phase<pg8::EpiResLn, pg8::PanelOrder, false>(C.lds, g, S, E); }
        else { pg8::StaticOrder S; S.init(M, DM, C.G, C.wg); pg8::EpiRes E{XB, TB, 1.0f};
            pg8::gemm_phase<pg8::EpiRes, pg8::StaticOrder, false>(C.lds, g, S, E); } } SEAM(11);
    if (IN(12)) { if (fuse_ln) p_router(C, XB, P.in[19], CNT, LIST, GATE, (int*)(ws + WS_PPOS));
        else p_layernorm<false, true, true>(C, TB, P.in[17], P.in[18], XB, nullptr, ws + WS_X8, P.in[19], CNT, LIST, GATE, (int*)(ws + WS_PPOS)); } SEAM(12);
    if (IN(13)) for (int rep_ = 0; rep_ < REP(13); ++rep_) { moe_tables(C, CNT);
        pg8::Gemm g{(const bf16*)(ws + WS_X8), (const bf16*)(ws + WS_MGU), DM, DM}; pg8::MoeOrder S; S.rep = REP(17); S.nM = tbase[16] >> 8; S.nN = 11; S.nwg = S.nM * 11; S.G = C.G; S.c = C.wg; S.tile0 = 0; S.tbase = tbase; S.tcnt = tcnt; S.tileg = tileg; S.list = LIST;
        pg8::EpiSwiglu8 E{ws + WS_MHID, EPAD, 11, 1.0f / (S8_X * S8_W1), 1};
        LAS int* rt = (LAS int*)(C.lds + LNX_OFF); S.rowtab = rt; const int nmine = C.wg < S.nwg * S.rep ? (S.nwg * S.rep - C.wg + C.G - 1) / C.G : 0;
        for (int base = 0; base < nmine; base += 12) { S.i0 = base; S.ilim = (nmine - base) < 12 ? (nmine - base) : 12;
            int tok[6]; int tid_o = C.tid; asm volatile("" : "+v"(tid_o));
#pragma unroll
            for (int k = 0; k < 6; ++k) { const int j = 2 * k + (C.wave >> 2); pg8::Unit u; (void)S.next(j < S.ilim ? j : 0, u); tok[k] = S.a_row_g(u, C.tid & 255); }
#pragma unroll
            for (int k = 0; k < 6; ++k) { const int idx = tid_o + 512 * k; if (idx < S.ilim * 256) rt[idx] = tok[k]; }
            __syncthreads();
            pg8::gemm_phase<pg8::EpiSwiglu8, pg8::MoeOrder, true, true>(C.lds, g, S, E); } } SEAM(13);
    if (IN(14)) { moe_tables(C, CNT);
        pg8::Gemm g{MHID, (const bf16*)(ws + WS_MDN), EPAD, EPAD}; pg8::MoeOrder S; S.rep = 1; S.nM = tbase[16] >> 8; S.nN = 8; S.nwg = S.nM * 8; S.G = C.G; S.c = C.wg; S.tile0 = 0; S.tbase = tbase; S.tcnt = tcnt; S.tileg = tileg; S.list = LIST; S.rowtab = nullptr; S.i0 = 0; S.ilim = 1 << 30;
        LAS float* gt = (LAS float*)(C.lds + LNX_OFF); const int nmine = C.wg < S.nwg ? (S.nwg - C.wg + C.G - 1) / C.G : 0;
        pg8::EpiMoePairs E{(bf16*)(ws + WS_OPAIR), gt, 1.0f / (S8_H * S8_W2), tbase, tcnt, tileg};
        for (int base = 0; base < nmine; base += 12) { S.i0 = base; S.ilim = (nmine - base) < 12 ? (nmine - base) : 12;
            float gv[6]; int tid_o = C.tid; asm volatile("" : "+v"(tid_o));
#pragma unroll
            for (int k = 0; k < 6; ++k) { const int j = 2 * k + (C.wave >> 2); pg8::Unit u; (void)S.next(j < S.ilim ? j : 0, u);
                const int gq = tileg[u.pm], pos = u.pm * 256 + (C.tid & 255) - tbase[gq], cq = tcnt[gq]; gv[k] = GATE[gq * LISTCAP + (pos < cq ? pos : cq - 1)]; }
#pragma unroll
            for (int k = 0; k < 6; ++k) { const int idx = tid_o + 512 * k; if (idx < S.ilim * 256) gt[idx] = gv[k]; }
            __syncthreads();
            pg8::gemm_phase<pg8::EpiMoePairs, pg8::MoeOrder, false, true>(C.lds, g, S, E); } } SEAM(14);
    if (IN(16)) { moe_tables(C, CNT); p_final_ln(C, XB, (const bf16*)(ws + WS_OPAIR), (const int*)(ws + WS_PPOS), P.in[22], P.in[23], OUT); }
#undef IN
#undef SEAM
}

extern "C" void kernel_launch(void* const* d_in, const int* in_sizes, int n_in, void* d_out, int out_size, void* d_ws, size_t ws_size, hipStream_t stream) {
    static int grid = 0;
    if (grid == 0) {
        if (n_in != 24 || in_sizes[0] != M * DM || out_size != M * DM || ws_size < WS_END) { fprintf(stderr, "kernel_launch: unexpected problem (n_in %d, in0 %d, out %d, ws %zu); nothing launched\n", n_in, n_in > 0 ? in_sizes[0] : -1, out_size, ws_size); grid = -1; return; }
        int dev = 0, cus = 0, per_cu = 0;
        if (hipGetDevice(&dev) != hipSuccess || hipDeviceGetAttribute(&cus, hipDeviceAttributeMultiprocessorCount, dev) != hipSuccess) { grid = -1; return; }
        if (hipFuncSetAttribute((const void*)fwd_kernel, hipFuncAttributeMaxDynamicSharedMemorySize, LDS_BYTES) != hipSuccess) { fprintf(stderr, "kernel_launch: hipFuncSetAttribute failed\n"); grid = -1; return; }
        if (hipOccupancyMaxActiveBlocksPerMultiprocessor(&per_cu, (const void*)fwd_kernel, 512, LDS_BYTES) != hipSuccess || per_cu < 1) { fprintf(stderr, "kernel_launch: occupancy query reports %d\n", per_cu); }
        (void)hipGetLastError();
        grid = cus;
    }
    if (grid < 0) return;
    if (hipMemsetAsync((char*)d_ws + WS_CTL, 0, CTL_ZERO_BYTES, stream) != hipSuccess) return;
    Ptrs p{};
    for (int i = 0; i < 24; ++i) p.in[i] = (const float*)d_in[i];
    p.out = (float*)d_out; p.ws = (unsigned char*)d_ws;
#if MK_PER_PHASE
    for (int k = 0; k < NPHASE; ++k) { p.ph_lo = k; p.ph_hi = k + 1; hipLaunchKernelGGL(fwd_kernel, dim3(grid), dim3(512), LDS_BYTES, stream, p); }
#else
    p.ph_lo = 0; p.ph_hi = NPHASE;
    hipLaunchKernelGGL(fwd_kernel, dim3(grid), dim3(512), LDS_BYTES, stream, p);
#endif
}
```

```cpp
#include <hip/hip_runtime.h>
#include <cstdio>
#include <cstdint>

#define LAS __attribute__((address_space(3)))
#define GAS __attribute__((address_space(1)))
typedef unsigned short bf16;
typedef short bf16x8 __attribute__((ext_vector_type(8)));
typedef short bf16x4 __attribute__((ext_vector_type(4)));
typedef float f32x4 __attribute__((ext_vector_type(4)));
typedef float f32x2 __attribute__((ext_vector_type(2)));
typedef float f32x16 __attribute__((ext_vector_type(16)));
typedef unsigned u32x4 __attribute__((ext_vector_type(4)));
typedef unsigned u32x2 __attribute__((ext_vector_type(2)));
typedef int i32x8 __attribute__((ext_vector_type(8)));

#define MK_PROBE_LO 0
#define MK_PROBE_HI -1
#define MK_PROBE_AMP 16
#define MK_PROBE_SUB 0
#ifndef MK_PER_PHASE
#define MK_PER_PHASE 0
#endif

constexpr int BATCH = 2, SEQ = 16384, DM = 2048, M = BATCH * SEQ;
constexpr int EVEN_IN = 4096, POOLW = 1024, FFN = 5632, NEXP = 8, EDIM = 1408;
constexpr float LN_EPS = 1e-5f, DN_ALPHA = 1.41421356237309515f;
constexpr int NPHASE = 17;
constexpr int EPAD = 1536;
constexpr int LISTCAP = 32768;
constexpr int MOE_ROWS = 2 * M + 16 * 256;

constexpr size_t MiB = 1u << 20;
constexpr size_t WS_CTL = 0, CTL_ZERO_BYTES = 163840;
constexpr size_t WS_WIN0 = 2 * MiB, WS_WOUT0 = 18 * MiB, WS_WGU = 26 * MiB, WS_WDN = 70 * MiB, WS_WIN1 = 92 * MiB, WS_WOUT1 = 108 * MiB, WS_MGU = 116 * MiB, WS_MDN = 204 * MiB, WS_PW = 248 * MiB;
constexpr size_t WS_XB = 250 * MiB;
constexpr size_t WS_TB = 378 * MiB;
constexpr size_t WS_R = 634 * MiB;
constexpr size_t WS_MISC = 1018 * MiB;
constexpr size_t WS_END = 1024 * MiB;
constexpr size_t WS_PROJ = WS_R, WS_MIX = WS_R + 256 * MiB, WS_HID = WS_R, WS_Z = WS_R, WS_SG = WS_R + 256 * MiB, WS_MHID = WS_R;
constexpr size_t WS_D = WS_TB + 128 * MiB, WS_VST = WS_TB + 192 * MiB, WS_X8 = WS_TB + 128 * MiB;
constexpr size_t WS_LNX = WS_TB + 208 * MiB;
constexpr size_t WS_WTMP = WS_TB + 200 * MiB;
constexpr size_t WS_OPAIR = WS_R + 104 * MiB;
constexpr size_t WS_PPOS = WS_MISC + 4 * MiB;
constexpr size_t WS_LIST = WS_MISC, WS_GATE = WS_MISC + 2 * MiB;
static_assert((size_t)MOE_ROWS * EPAD <= 104 * MiB && 104 * MiB + (size_t)MOE_ROWS * DM * 2 <= 384 * MiB && (size_t)MOE_ROWS * EDIM * 2 <= 384 * MiB && (size_t)M * FFN * 2 <= 384 * MiB, "R region");
constexpr int CW_CNT = 64;
constexpr int CW_PAN = 8192;
constexpr int CW_BAR = 4096;

constexpr int RING_BYTES = 131072;
constexpr int MISC_OFF = RING_BYTES + 320;
constexpr int LNX_OFF = RING_BYTES + 4096;
constexpr int TAB_OFF = RING_BYTES + 1024;
constexpr int LDS_BYTES = 147456;

#define RLX_AGENT __ATOMIC_RELAXED, __HIP_MEMORY_SCOPE_AGENT
#define LDS_WAIT() asm volatile("s_waitcnt lgkmcnt(0)" ::: "memory")

__device__ __forceinline__ unsigned cvt_pk_bf16(float lo, float hi) { unsigned r; asm volatile("v_cvt_pk_bf16_f32 %0, %1, %2" : "=v"(r) : "v"(lo), "v"(hi)); return r; }
#ifndef WT_STORES
#define WT_STORES 0
#endif
__device__ __forceinline__ void st16(void* p, u32x4 v) {
#if WT_STORES
    asm volatile("global_store_dwordx4 %0, %1, off sc1\n\ts_nop 1" :: "v"(p), "v"(v) : "memory");
#else
    *(u32x4*)p = v;
#endif
}
__device__ __forceinline__ void st16f(void* p, f32x4 v) {
#if WT_STORES
    asm volatile("global_store_dwordx4 %0, %1, off sc1\n\ts_nop 1" :: "v"(p), "v"(v) : "memory");
#else
    *(f32x4*)p = v;
#endif
}
__device__ __forceinline__ void st8(void* p, u32x2 v) {
#if WT_STORES
    asm volatile("global_store_dwordx2 %0, %1, off sc1\n\ts_nop 1" :: "v"(p), "v"(v) : "memory");
#else
    *(u32x2*)p = v;
#endif
}
__device__ __forceinline__ float bf_lo(unsigned w) { return __uint_as_float(w << 16); }
__device__ __forceinline__ float bf_hi(unsigned w) { return __uint_as_float(w & 0xffff0000u); }
__device__ __forceinline__ float clamp448(float x) { return __builtin_amdgcn_fmed3f(x, -448.0f, 448.0f); }
__device__ __forceinline__ unsigned pk4_fp8(float a, float b, float c, float d) {
    int w = 0; w = __builtin_amdgcn_cvt_pk_fp8_f32(clamp448(a), clamp448(b), w, false); w = __builtin_amdgcn_cvt_pk_fp8_f32(clamp448(c), clamp448(d), w, true); return (unsigned)w; }
constexpr float S8_X = 16.0f, S8_W1 = 512.0f, S8_H = 16.0f, S8_W2 = 2048.0f;
__device__ __forceinline__ float wave_sum(float v) {
#pragma unroll
    for (int o = 1; o < 64; o <<= 1) v += __shfl_xor(v, o);
    return v;
}
__device__ __forceinline__ float fast_rcp(float x) { return __builtin_amdgcn_rcpf(x); }
__device__ __forceinline__ float silu_f(float g) { return g * fast_rcp(1.0f + __builtin_amdgcn_exp2f(-1.4426950408889634f * g)); }
__device__ __forceinline__ float gelu_tanh_f(float x) { const float y = x * (1.0f + 0.044715f * x * x); return x * fast_rcp(1.0f + __builtin_amdgcn_exp2f(-2.302208198f * y)); }

namespace pg8 {
constexpr int BM = 256, BK = 64, HALF = 128, HTB = HALF * BK * 2, STAGE_BYTES = 8 * HTB, NXCD = 8, WGM = 8;
__host__ __device__ __forceinline__ int lds_byte(int r, int c) { const int st = (r >> 4) * 2 + (c >> 5), rr = r & 15, cc = c & 31, ob = rr * 64 + cc * 2; return st * 1024 + (ob ^ (((ob >> 9) & 1) << 5)); }
__host__ __device__ __forceinline__ void stage_rc(int b, int& R, int& C) { const int st = b / 1024, sb = b % 1024, swz = sb ^ (((sb >> 9) & 1) << 5); R = (st >> 1) * 16 + swz / 64; C = (st & 1) * 32 + (swz % 64) / 2; }
__host__ __device__ __forceinline__ int perm32(int rho) { const int n = rho >> 4, i = rho & 15; return 8 * (i >> 2) + 4 * n + (i & 3); }

struct Unit { int pm, pn, ord; };
struct Gemm { const bf16* A; const bf16* Bt; int K; int lda; };

struct StaticOrder {
    int nM, nN, nwg, G, c;
    __device__ void init(int Mr, int N, int G_, int c_) { nM = Mr / BM; nN = N / BM; nwg = nM * nN; G = G_; c = c_; }
    __device__ bool next(int i, Unit& u) const {
        const long L = (long)i * G + c; if (L >= nwg) return false;
        int wgid = (int)L; { const int q = nwg / NXCD, r = nwg % NXCD, xcd = wgid % NXCD, off = wgid / NXCD; wgid = (xcd < r ? xcd * (q + 1) : r * (q + 1) + (xcd - r) * q) + off; }
        const int nig = WGM * nN, gid = wgid / nig, fm = gid * WGM, gsz = (nM - fm) < WGM ? (nM - fm) : WGM;
        u.pm = fm + ((wgid % nig) % gsz); u.pn = (wgid % nig) / gsz; return true;
    }
    __device__ __forceinline__ int a_row(const Unit&, int, int) const { return 0; }
    __device__ __forceinline__ size_t a_coloff(const Unit&) const { return 0; }
};
struct PanelOrder {
    int c;
    __device__ bool next(int i, Unit& u) const { if (i >= 4) return false; const int x = c & 7, j = c >> 3; u.pm = 16 * x + 4 * i + (j >> 3); u.pn = j & 7; return true; }
    __device__ __forceinline__ int a_row(const Unit&, int, int) const { return 0; }
    __device__ __forceinline__ size_t a_coloff(const Unit&) const { return 0; }
};
struct FoldOrder {
    int c;
    __device__ bool next(int i, Unit& u) const { if (i > 0 || c >= 32) return false; u.pm = c & 7; u.pn = c >> 3; return true; }
    __device__ __forceinline__ int a_row(const Unit&, int, int) const { return 0; }
    __device__ __forceinline__ size_t a_coloff(const Unit& u) const { return (size_t)u.pn * 512; }
};
struct MoeOrder {
    int nM, nN, nwg, G, c, tile0, rep;
    const LAS int* tbase; const LAS int* tcnt; const LAS unsigned char* tileg; const int* list;
    __device__ __forceinline__ bool next(int i, Unit& u) const {
        if (i >= ilim) return false;
        const long L0 = (long)(i + i0) * G + c; if (L0 >= (long)nwg * rep) return false; const long L = L0 % nwg;
        int wgid = (int)L; { const int q = nwg / NXCD, r = nwg % NXCD, xcd = wgid % NXCD, off = wgid / NXCD; wgid = (xcd < r ? xcd * (q + 1) : r * (q + 1) + (xcd - r) * q) + off; }
        const int nig = WGM * nN, gid = wgid / nig, fm = gid * WGM, gsz = (nM - fm) < WGM ? (nM - fm) : WGM;
        const int pm = tile0 + fm + ((wgid % nig) % gsz), pnl = (wgid % nig) / gsz;
        u.pm = pm; u.pn = (int)(tileg[pm] & 7) * nN + pnl; u.ord = i; return true;
    }
    const LAS int* rowtab; int i0, ilim;
    __device__ __forceinline__ int a_row_g(const Unit& u, int r) const {
        const int g = tileg[u.pm], pos = u.pm * 256 + r - tbase[g], c = tcnt[g];
        return list[g * LISTCAP + (pos < c ? pos : c - 1)];
    }
    __device__ __forceinline__ int a_row(const Unit&, int r, int ord) const { return rowtab[ord * 256 + r]; }
    __device__ __forceinline__ size_t a_coloff(const Unit&) const { return 0; }
};

struct EpiBf16 {
    static constexpr bool PERM = true;
    bf16* O; int ldc;
    __device__ __forceinline__ void operator()(const f32x4 (&acc)[2][2][4][2], const Unit& u, int wr, int wc, int fr, int fq) const {
        const int row0 = u.pm * BM + wr * 64 + fr, col0 = u.pn * BM + wc * 32 + 8 * fq;
#pragma unroll
        for (int ai = 0; ai < 2; ++ai)
#pragma unroll
            for (int m = 0; m < 4; ++m) { bf16* rowp = O + (size_t)(row0 + ai * HALF + m * 16) * ldc + col0;
#pragma unroll
                for (int bj = 0; bj < 2; ++bj) { const f32x4 v0 = acc[ai][bj][m][0], v1 = acc[ai][bj][m][1];
                    u32x4 w; w.x = cvt_pk_bf16(v0[0], v0[1]); w.y = cvt_pk_bf16(v0[2], v0[3]); w.z = cvt_pk_bf16(v1[0], v1[1]); w.w = cvt_pk_bf16(v1[2], v1[3]);
                    st16(rowp + bj * HALF, w); } }
    }
};
struct EpiGeluStats {
    static constexpr bool PERM = true;
    bf16* O; f32x2* vst;
    static __device__ __forceinline__ f32x2 gelu2(f32x2 x) {
        const f32x2 CK = {0.044715f * -2.302208198f, 0.044715f * -2.302208198f}, KK = {-2.302208198f, -2.302208198f}, ONE = {1.0f, 1.0f};
        const f32x2 a = x * __builtin_elementwise_fma(x * x, CK, KK);
        const f32x2 d = (f32x2){__builtin_amdgcn_exp2f(a[0]), __builtin_amdgcn_exp2f(a[1])} + ONE;
        return x * (f32x2){fast_rcp(d[0]), fast_rcp(d[1])};
    }
    template <bool ST>
    __device__ __forceinline__ void body(const f32x4 (&acc)[2][2][4][2], const Unit& u, int wr, int wc, int fr, int fq) const {
        const int row0 = u.pm * BM + wr * 64 + fr, col0 = u.pn * BM + wc * 32 + 8 * fq;
#pragma unroll
        for (int ai = 0; ai < 2; ++ai)
#pragma unroll
            for (int m = 0; m < 4; ++m) { const int row = row0 + ai * HALF + m * 16; bf16* rowp = O + (size_t)row * 4096 + col0; f32x2 s1 = {0.f, 0.f}, s2 = {0.f, 0.f};
#pragma unroll
                for (int bj = 0; bj < 2; ++bj) { const f32x4 v0 = acc[ai][bj][m][0], v1 = acc[ai][bj][m][1];
                    const f32x2 y0 = gelu2((f32x2){v0[0], v0[1]}), y1 = gelu2((f32x2){v0[2], v0[3]}), y2 = gelu2((f32x2){v1[0], v1[1]}), y3 = gelu2((f32x2){v1[2], v1[3]});
                    if (ST) { s1 += (y0 + y1) + (y2 + y3); s2 = __builtin_elementwise_fma(y0, y0, s2); s2 = __builtin_elementwise_fma(y1, y1, s2); s2 = __builtin_elementwise_fma(y2, y2, s2); s2 = __builtin_elementwise_fma(y3, y3, s2); }
                    u32x4 w; w.x = cvt_pk_bf16(y0[0], y0[1]); w.y = cvt_pk_bf16(y1[0], y1[1]); w.z = cvt_pk_bf16(y2[0], y2[1]); w.w = cvt_pk_bf16(y3[0], y3[1]);
                    st16(rowp + bj * HALF, w); }
                if (ST) { float t1 = s1[0] + s1[1], t2 = s2[0] + s2[1]; t1 += __shfl_xor(t1, 16); t1 += __shfl_xor(t1, 32); t2 += __shfl_xor(t2, 16); t2 += __shfl_xor(t2, 32);
                    if (fq == 0) vst[(size_t)row * 32 + (u.pn - 8) * 4 + wc] = (f32x2){t1, t2}; } }
    }
    __device__ __forceinline__ void operator()(const f32x4 (&acc)[2][2][4][2], const Unit& u, int wr, int wc, int fr, int fq) const {
        if (u.pn >= 8) body<true>(acc, u, wr, wc, fr, fq); else body<false>(acc, u, wr, wc, fr, fq);
    }
};
struct EpiRes {
    static constexpr bool PERM = true;
    const bf16* res; bf16* T; float asc;
    __device__ __forceinline__ void operator()(const f32x4 (&acc)[2][2][4][2], const Unit& u, int wr, int wc, int fr, int fq) const {
        const int row0 = u.pm * BM + wr * 64 + fr, col0 = u.pn * BM + wc * 32 + 8 * fq;
        u32x4 rr[2][4][2];
#pragma unroll
        for (int ai = 0; ai < 2; ++ai)
#pragma unroll
            for (int m = 0; m < 4; ++m) { const bf16* rp_ = res + (size_t)(row0 + ai * HALF + m * 16) * DM + col0;
#pragma unroll
                for (int bj = 0; bj < 2; ++bj) rr[ai][m][bj] = *(const u32x4*)(rp_ + bj * HALF); }
#pragma unroll
        for (int ai = 0; ai < 2; ++ai)
#pragma unroll
            for (int m = 0; m < 4; ++m) { const size_t off = (size_t)(row0 + ai * HALF + m * 16) * DM + col0;
#pragma unroll
                for (int bj = 0; bj < 2; ++bj) { const u32x4 r = rr[ai][m][bj]; const f32x4 v0 = acc[ai][bj][m][0] * asc, v1 = acc[ai][bj][m][1] * asc;
                    u32x4 w; w.x = cvt_pk_bf16(bf_lo(r.x) * DN_ALPHA + v0[0], bf_hi(r.x) * DN_ALPHA + v0[1]); w.y = cvt_pk_bf16(bf_lo(r.y) * DN_ALPHA + v0[2], bf_hi(r.y) * DN_ALPHA + v0[3]);
                    w.z = cvt_pk_bf16(bf_lo(r.z) * DN_ALPHA + v1[0], bf_hi(r.z) * DN_ALPHA + v1[1]); w.w = cvt_pk_bf16(bf_lo(r.w) * DN_ALPHA + v1[2], bf_hi(r.w) * DN_ALPHA + v1[3]);
                    st16(T + off + bj * HALF, w); } }
    }
};
struct EpiResLn {
    static constexpr bool PERM = true;
    const bf16* res; bf16* XBo; float asc; const float* gam; const float* bet; unsigned long long* slots; unsigned* cnt; LAS unsigned char* sp; unsigned char* X8o;
    __device__ __forceinline__ void operator()(f32x4 (&acc)[2][2][4][2], const Unit& u, int wr, int wc, int fr, int fq) const {
        const int tid = threadIdx.x, lane = tid & 63, wid = tid >> 6;
        const int row0 = u.pm * BM + wr * 64 + fr, col0 = u.pn * BM + wc * 32 + 8 * fq;
        LAS f32x2* Pt = (LAS f32x2*)sp; LAS f32x2* St = (LAS f32x2*)(sp + 8192);
        const f32x2 AL2 = {DN_ALPHA, DN_ALPHA}, AS2 = {asc, asc};
#pragma unroll
        for (int ai = 0; ai < 2; ++ai) { u32x4 rr[4][2];
#pragma unroll
            for (int m = 0; m < 4; ++m) { const bf16* rp_ = res + (size_t)(row0 + ai * HALF + m * 16) * DM + col0;
#pragma unroll
                for (int bj = 0; bj < 2; ++bj) rr[m][bj] = *(const u32x4*)(rp_ + bj * HALF); }
#pragma unroll
            for (int m = 0; m < 4; ++m) { f32x2 p1 = {0.f, 0.f}, p2 = {0.f, 0.f};
#pragma unroll
                for (int bj = 0; bj < 2; ++bj) { const u32x4 r = rr[m][bj];
#pragma unroll
                    for (int q = 0; q < 4; ++q) { const unsigned w = r[q]; const f32x2 x2 = {bf_lo(w), bf_hi(w)}, a2 = {acc[ai][bj][m][q >> 1][2 * (q & 1)], acc[ai][bj][m][q >> 1][2 * (q & 1) + 1]};
                        const f32x2 t2 = __builtin_elementwise_fma(x2, AL2, a2 * AS2);
                        acc[ai][bj][m][q >> 1][2 * (q & 1)] = t2[0]; acc[ai][bj][m][q >> 1][2 * (q & 1) + 1] = t2[1];
                        p1 += t2; p2 = __builtin_elementwise_fma(t2, t2, p2); } }
                float s1 = p1[0] + p1[1], s2 = p2[0] + p2[1];
                s1 += __shfl_xor(s1, 16); s1 += __shfl_xor(s1, 32); s2 += __shfl_xor(s2, 16); s2 += __shfl_xor(s2, 32);
                if (fq == 0) Pt[(ai * HALF + wr * 64 + m * 16 + fr) * 4 + wc] = (f32x2){s1, s2}; }
            asm volatile("" ::: "memory"); }
        asm volatile("s_waitcnt lgkmcnt(0)" ::: "memory"); __builtin_amdgcn_s_barrier(); asm volatile("" ::: "memory");
        if (tid < 256) { const f32x2 a = Pt[tid * 4 + 0], b = Pt[tid * 4 + 1], c = Pt[tid * 4 + 2], d = Pt[tid * 4 + 3];
            const float S1 = (a[0] + b[0]) + (c[0] + d[0]), S2 = (a[1] + b[1]) + (c[1] + d[1]);
            unsigned long long* sl = slots + (size_t)(u.pm * BM + tid) * 8;
            __hip_atomic_store(sl + u.pn, ((unsigned long long)(__float_as_uint(S2) | 1u) << 32) | __float_as_uint(S1), __ATOMIC_RELAXED, __HIP_MEMORY_SCOPE_AGENT);
            unsigned long long wv[8]; unsigned sp_ = 0;
            for (;;) { unsigned ok = 1u;
#pragma unroll
                for (int t = 0; t < 8; ++t) { wv[t] = __hip_atomic_load(sl + t, __ATOMIC_RELAXED, __HIP_MEMORY_SCOPE_AGENT); }
#pragma unroll
                for (int t = 0; t < 8; ++t) ok &= ((unsigned)(wv[t] >> 32) != 0u) ? 1u : 0u;
                if (ok) break;
                __builtin_amdgcn_s_sleep(1); if (++sp_ > (1u << 18)) break; }
            float T1 = 0.f, T2 = 0.f;
#pragma unroll
            for (int t = 0; t < 8; ++t) { T1 += __uint_as_float((unsigned)wv[t]); T2 += __uint_as_float((unsigned)(wv[t] >> 32)); }
            const float mean = T1 * (1.0f / DM), var = fmaxf(T2 * (1.0f / DM) - mean * mean, 0.f);
            St[tid] = (f32x2){mean, 1.0f / sqrtf(var + LN_EPS)}; }
        asm volatile("s_waitcnt vmcnt(0) lgkmcnt(0)" ::: "memory"); __builtin_amdgcn_s_barrier(); asm volatile("" ::: "memory");
#pragma unroll
        for (int bj = 0; bj < 2; ++bj) { const f32x4 g0 = *(const f32x4*)(gam + col0 + bj * HALF), g1 = *(const f32x4*)(gam + col0 + bj * HALF + 4), b0 = *(const f32x4*)(bet + col0 + bj * HALF), b1 = *(const f32x4*)(bet + col0 + bj * HALF + 4);
            const f32x2 G2[4] = {{g0[0], g0[1]}, {g0[2], g0[3]}, {g1[0], g1[1]}, {g1[2], g1[3]}}, B2[4] = {{b0[0], b0[1]}, {b0[2], b0[3]}, {b1[0], b1[1]}, {b1[2], b1[3]}};
            const f32x2 SX2 = {S8_X, S8_X};
            const f32x2 G8[4] = {G2[0] * SX2, G2[1] * SX2, G2[2] * SX2, G2[3] * SX2}, B8[4] = {B2[0] * SX2, B2[1] * SX2, B2[2] * SX2, B2[3] * SX2};
#pragma unroll
            for (int ai = 0; ai < 2; ++ai)
#pragma unroll
                for (int m = 0; m < 4; ++m) { const f32x2 ms = St[ai * HALF + wr * 64 + m * 16 + fr];
                    const f32x2 R2 = {ms[1], ms[1]}, M2 = {-ms[0] * ms[1], -ms[0] * ms[1]};
                    f32x2 t[4], y[4];
#pragma unroll
                    for (int q = 0; q < 4; ++q) { const f32x2 a2 = {acc[ai][bj][m][q >> 1][2 * (q & 1)], acc[ai][bj][m][q >> 1][2 * (q & 1) + 1]};
                        t[q] = __builtin_elementwise_fma(a2, R2, M2); y[q] = __builtin_elementwise_fma(t[q], G2[q], B2[q]); }
                    u32x4 w; w.x = cvt_pk_bf16(y[0][0], y[0][1]); w.y = cvt_pk_bf16(y[1][0], y[1][1]); w.z = cvt_pk_bf16(y[2][0], y[2][1]); w.w = cvt_pk_bf16(y[3][0], y[3][1]);
                    st16(XBo + (size_t)(row0 + ai * HALF + m * 16) * DM + col0 + bj * HALF, w);
                    if (X8o) { f32x2 z[4];
#pragma unroll
                        for (int q = 0; q < 4; ++q) z[q] = __builtin_elementwise_fma(t[q], G8[q], B8[q]);
                        u32x2 w8; w8.x = pk4_fp8(z[0][0], z[0][1], z[1][0], z[1][1]); w8.y = pk4_fp8(z[2][0], z[2][1], z[3][0], z[3][1]);
                        st8(X8o + (size_t)(row0 + ai * HALF + m * 16) * DM + col0 + bj * HALF, w8); } } }
    }
};
struct EpiSwiglu8 {
    static constexpr bool PERM = true;
    unsigned char* H; int ldh, NT; float asc; int zpad;
    __device__ __forceinline__ void operator()(const f32x4 (&acc)[2][2][4][2], const Unit& u, int wr, int wc, int fr, int fq) const {
        const int row0 = u.pm * BM + wr * 64 + fr, col0 = (u.pn % NT) * HALF + wc * 32 + 8 * fq;
        const float cc = asc * asc * S8_H, kk = -1.4426950408889634f * asc, bb = -__builtin_amdgcn_logf(cc), ic = fast_rcp(cc);
        const f32x2 K2 = {kk, kk}, B2 = {bb, bb}, IC2 = {ic, ic};
#pragma unroll
        for (int ai = 0; ai < 2; ++ai)
#pragma unroll
            for (int m = 0; m < 4; ++m) { unsigned char* rowp = H + (size_t)(row0 + ai * HALF + m * 16) * ldh + col0; float o[8];
#pragma unroll
                for (int n = 0; n < 2; ++n)
#pragma unroll
                    for (int h = 0; h < 2; ++h) {
                        const f32x2 g2 = {acc[ai][0][m][n][2 * h], acc[ai][0][m][n][2 * h + 1]}, u2 = {acc[ai][1][m][n][2 * h], acc[ai][1][m][n][2 * h + 1]};
                        const f32x2 a2 = __builtin_elementwise_fma(g2, K2, B2);
                        const f32x2 d2 = (f32x2){__builtin_amdgcn_exp2f(a2[0]), __builtin_amdgcn_exp2f(a2[1])} + IC2;
                        const f32x2 o2 = (g2 * u2) * (f32x2){fast_rcp(d2[0]), fast_rcp(d2[1])};
                        o[4 * n + 2 * h] = o2[0]; o[4 * n + 2 * h + 1] = o2[1]; }
                u32x2 w; w.x = pk4_fp8(o[0], o[1], o[2], o[3]); w.y = pk4_fp8(o[4], o[5], o[6], o[7]);
                st8(rowp, w);
                if (zpad && (u.pn % NT) == NT - 1) { const u32x2 z = {0u, 0u}; st8(rowp + HALF, z); } }
    }
};
struct EpiMoePairs {
    static constexpr bool PERM = true;
    bf16* O; const LAS float* gtab; float asc;
    const LAS int* tbase; const LAS int* tcnt; const LAS unsigned char* tileg;
    __device__ __forceinline__ void operator()(const f32x4 (&acc)[2][2][4][2], const Unit& u, int wr, int wc, int fr, int fq) const {
        const int g = tileg[u.pm], pos0 = u.pm * BM - tbase[g], cnt = tcnt[g];
        const int col0 = (u.pn & 7) * BM + wc * 32 + 8 * fq;
        float gt[2][4];
#pragma unroll
        for (int ai = 0; ai < 2; ++ai)
#pragma unroll
            for (int m = 0; m < 4; ++m) gt[ai][m] = gtab[u.ord * 256 + ai * HALF + wr * 64 + m * 16 + fr];
#pragma unroll
        for (int ai = 0; ai < 2; ++ai)
#pragma unroll
            for (int m = 0; m < 4; ++m) { const int rl = ai * HALF + wr * 64 + m * 16 + fr, pos = pos0 + rl;
                if (pos < cnt) { const float gs = gt[ai][m] * asc; bf16* rowp = O + (size_t)(u.pm * BM + rl) * DM + col0;
#pragma unroll
                    for (int bj = 0; bj < 2; ++bj) { const f32x4 v0 = acc[ai][bj][m][0] * gs, v1 = acc[ai][bj][m][1] * gs;
                        u32x4 w; w.x = cvt_pk_bf16(v0[0], v0[1]); w.y = cvt_pk_bf16(v0[2], v0[3]); w.z = cvt_pk_bf16(v1[0], v1[1]); w.w = cvt_pk_bf16(v1[2], v1[3]);
                        st16(rowp + bj * HALF, w); } } }
    }
};

template <class Epi, class Sched, bool GATHER, bool F8 = false>
__device__ __forceinline__ void gemm_phase(LAS unsigned char* lds, const Gemm g, const Sched& S, const Epi& E) {
    const int tid = threadIdx.x, wid = __builtin_amdgcn_readfirstlane(tid >> 6), lane = tid & 63, wr = wid >> 2, wc = wid & 3, fr = lane & 15, fq = lane >> 4;
    constexpr int ES = F8 ? 1 : 2;
    const int K = g.K, nt = K * ES / (BK * 2), lda = g.lda;
    unsigned voffB[2]; int RA[2], CA[2];
#pragma unroll
    for (int i = 0; i < 2; ++i) { int R, C; stage_rc(tid * 16 + i * 8192, R, C); const int Rb = Epi::PERM ? ((R & ~31) + perm32(R & 31)) : R;
        RA[i] = R; CA[i] = C; voffB[i] = (unsigned)(Rb * K) * ES + (unsigned)C * 2u; }
    const size_t kstep = (size_t)(BK * 2);
    const size_t hstep = (size_t)HALF * K * ES;
    const size_t tstep = 2 * hstep;
    const size_t hstepA = (size_t)HALF * lda * ES, tstepA = 2 * hstepA;
    const unsigned ldsw = (unsigned)wid * 1024u;
    const int aoff = lds_byte(wr * 64 + fr, fq * 8), boff = lds_byte(wc * 32 + fr, fq * 8);
#define PG8_SA(b, h) (((b) * 2 + (h)) * HTB)
#define PG8_SB(b, h) ((4 + (b) * 2 + (h)) * HTB)
#define PG8_STAGE(bufoff, gbase, voff) do { _Pragma("unroll") for (int _i = 0; _i < 2; ++_i) \
        __builtin_amdgcn_global_load_lds((const unsigned*)((const char*)(gbase) + (voff)[_i]), (LAS unsigned*)(lds + (bufoff) + ldsw + _i * 8192), 16, 0, 0); } while (0)
#define PG8_LD8(p) __builtin_bit_cast(i32x8, __builtin_shufflevector(*(const LAS u32x4*)(p), *(const LAS u32x4*)((p) + 1024), 0, 1, 2, 3, 4, 5, 6, 7))
#define PG8_LDA(dst, b, h) do { if (F8) { _Pragma("unroll") for (int m = 0; m < 4; ++m) dst##8[m] = PG8_LD8(lds + PG8_SA(b, h) + aoff + m * 2048); } \
        else { _Pragma("unroll") for (int m = 0; m < 4; ++m) _Pragma("unroll") for (int k = 0; k < 2; ++k) dst[m][k] = *(const LAS bf16x8*)(lds + PG8_SA(b, h) + aoff + m * 2048 + k * 1024); } } while (0)
#define PG8_LDB(dst, b, h) do { if (F8) { _Pragma("unroll") for (int n = 0; n < 2; ++n) dst##8[n] = PG8_LD8(lds + PG8_SB(b, h) + boff + n * 2048); } \
        else { _Pragma("unroll") for (int n = 0; n < 2; ++n) _Pragma("unroll") for (int k = 0; k < 2; ++k) dst[n][k] = *(const LAS bf16x8*)(lds + PG8_SB(b, h) + boff + n * 2048 + k * 1024); } } while (0)
#define PG8_CAT(X) __builtin_shufflevector(__builtin_bit_cast(u32x4, (X)[0]), __builtin_bit_cast(u32x4, (X)[1]), 0, 1, 2, 3, 4, 5, 6, 7)
#define PG8_MMA(ai, bj, At, Bt) do { __builtin_amdgcn_s_setprio(1); \
        if (F8) { _Pragma("unroll") for (int m = 0; m < 4; ++m) _Pragma("unroll") for (int n = 0; n < 2; ++n) \
            asm volatile("v_mfma_scale_f32_16x16x128_f8f6f4 %0, %1, %2, %0, %3, %3 op_sel_hi:[0,0,0]" : "+v"(acc[ai][bj][m][n]) : "v"(Bt##8[n]), "v"(At##8[m]), "v"(one_scale)); } \
        else { _Pragma("unroll") for (int m = 0; m < 4; ++m) _Pragma("unroll") for (int n = 0; n < 2; ++n) _Pragma("unroll") for (int k = 0; k < 2; ++k) \
            acc[ai][bj][m][n] = __builtin_amdgcn_mfma_f32_16x16x32_bf16(Bt[n][k], At[m][k], acc[ai][bj][m][n], 0, 0, 0); } \
        __builtin_amdgcn_s_setprio(0); } while (0)
#define PG8_WAIT_V(n) asm volatile("s_waitcnt vmcnt(" #n ")" ::: "memory")
#define PG8_WAIT_L(n) asm volatile("s_waitcnt lgkmcnt(" #n ")" ::: "memory")
#define PG8_BAR __builtin_amdgcn_s_barrier()
#define PG8_SCHED __builtin_amdgcn_sched_barrier(0)
    Unit cur, nxt; int ui = 0;
    if (!S.next(0, cur)) return;
    f32x4 acc[2][2][4][2];
#pragma unroll
    for (int a = 0; a < 2; ++a)
#pragma unroll
        for (int b = 0; b < 2; ++b)
#pragma unroll
            for (int m = 0; m < 4; ++m)
#pragma unroll
                for (int n = 0; n < 2; ++n) acc[a][b][m][n] = (f32x4){0.f, 0.f, 0.f, 0.f};
    bf16x8 At[4][2], B0[2][2], B1[2][2]; i32x8 At8[4], B08[2], B18[2]; const int one_scale = 0x7f7f7f7f;
    unsigned cv0[2], cv1[2], nv0[2], nv1[2];
#define PG8_ROWS(U, V0, V1, ORD) do { _Pragma("unroll") for (int _i = 0; _i < 2; ++_i) { \
        if (GATHER) { V0[_i] = (unsigned)(S.a_row(U, RA[_i], ORD) * lda) * ES + (unsigned)CA[_i] * 2u; V1[_i] = (unsigned)(S.a_row(U, HALF + RA[_i], ORD) * lda) * ES + (unsigned)CA[_i] * 2u; } \
        else { V0[_i] = (unsigned)(RA[_i] * lda) * ES + (unsigned)CA[_i] * 2u; V1[_i] = 0u; } } } while (0)
#define PG8_STAGE_A(bufoff, gbase, hf, V0, V1) do { if (GATHER) { if (hf) PG8_STAGE(bufoff, gbase, V1); else PG8_STAGE(bufoff, gbase, V0); } \
        else PG8_STAGE(bufoff, (gbase) + ((hf) ? hstepA : 0), V0); } while (0)
    PG8_ROWS(cur, cv0, cv1, 0);
    const char* cA = GATHER ? (const char*)g.A : (const char*)g.A + (size_t)cur.pm * tstepA + S.a_coloff(cur); const char* cB = (const char*)g.Bt + (size_t)cur.pn * tstep;
    PG8_STAGE(PG8_SB(0, 0), cB, voffB); PG8_STAGE(PG8_SB(0, 1), cB + hstep, voffB); PG8_STAGE_A(PG8_SA(0, 0), cA, 0, cv0, cv1); PG8_STAGE_A(PG8_SA(0, 1), cA, 1, cv0, cv1);
    if (wr == 1) PG8_BAR;
    PG8_WAIT_V(2); PG8_BAR;
    PG8_STAGE(PG8_SB(1, 0), cB + kstep, voffB); PG8_STAGE_A(PG8_SA(1, 0), cA + kstep, 0, cv0, cv1); PG8_STAGE(PG8_SB(1, 1), cB + hstep + kstep, voffB);
    PG8_WAIT_V(6); PG8_BAR;
    for (;;) {
        const bool has_next = S.next(ui + 1, nxt);
        const char* nA = GATHER ? (const char*)g.A : (has_next ? (const char*)g.A + (size_t)nxt.pm * tstepA + S.a_coloff(nxt) : cA); const char* nB = has_next ? (const char*)g.Bt + (size_t)nxt.pn * tstep : cB;
        if (GATHER && has_next) PG8_ROWS(nxt, nv0, nv1, ui + 1); else {
#pragma unroll
            for (int _i = 0; _i < 2; ++_i) { nv0[_i] = cv0[_i]; nv1[_i] = cv1[_i]; } }
        for (int t = 0; t < nt; t += 2) {
            const bool last = (t == nt - 2);
            const char* a1 = cA + (size_t)(t + 1) * kstep;
            const char* a2 = last ? nA : cA + (size_t)(t + 2) * kstep; const char* b2 = last ? nB : cB + (size_t)(t + 2) * kstep;
            const char* a3 = a2 + kstep; const char* b3 = b2 + kstep;
            unsigned w0[2], w1[2];
#pragma unroll
            for (int _i = 0; _i < 2; ++_i) { w0[_i] = last ? nv0[_i] : cv0[_i]; w1[_i] = last ? nv1[_i] : cv1[_i]; }
            PG8_LDB(B0, 0, 0); PG8_LDB(B1, 0, 1); PG8_SCHED; PG8_LDA(At, 0, 0); PG8_STAGE_A(PG8_SA(1, 1), a1, 1, cv0, cv1);
            PG8_WAIT_V(8); PG8_WAIT_L(0); PG8_BAR; PG8_MMA(0, 0, At, B0); PG8_MMA(0, 1, At, B1); PG8_BAR; PG8_SCHED;
            PG8_LDA(At, 0, 1); PG8_STAGE(PG8_SB(0, 0), b2, voffB); PG8_STAGE(PG8_SB(0, 1), b2 + hstep, voffB); PG8_STAGE_A(PG8_SA(0, 0), a2, 0, w0, w1);
            PG8_WAIT_V(8); PG8_WAIT_L(0); PG8_BAR; PG8_MMA(1, 0, At, B0); PG8_MMA(1, 1, At, B1); PG8_BAR; PG8_SCHED;
            PG8_LDB(B0, 1, 0); PG8_LDB(B1, 1, 1); PG8_SCHED; PG8_LDA(At, 1, 0); PG8_STAGE_A(PG8_SA(0, 1), a2, 1, w0, w1);
            PG8_WAIT_V(8); PG8_WAIT_L(0); PG8_BAR; PG8_MMA(0, 0, At, B0); PG8_MMA(0, 1, At, B1); PG8_BAR; PG8_SCHED;
            PG8_LDA(At, 1, 1); PG8_STAGE(PG8_SB(1, 0), b3, voffB); PG8_STAGE(PG8_SB(1, 1), b3 + hstep, voffB); PG8_STAGE_A(PG8_SA(1, 0), a3, 0, w0, w1);
            PG8_WAIT_V(8); PG8_WAIT_L(0); PG8_BAR; PG8_MMA(1, 0, At, B0); PG8_MMA(1, 1, At, B1); PG8_BAR; PG8_SCHED;
        }
        if (wr == 0) PG8_BAR;
        if (F8) asm volatile("s_nop 15\n\ts_nop 15" ::: "memory");
        E(acc, cur, wr, wc, fr, fq);
        if (!has_next) break;
#pragma unroll
        for (int a = 0; a < 2; ++a)
#pragma unroll
            for (int b = 0; b < 2; ++b)
#pragma unroll
                for (int m = 0; m < 4; ++m)
#pragma unroll
                    for (int n = 0; n < 2; ++n) acc[a][b][m][n] = (f32x4){0.f, 0.f, 0.f, 0.f};
        cur = nxt; cA = nA; cB = nB; ++ui;
#pragma unroll
        for (int _i = 0; _i < 2; ++_i) { cv0[_i] = nv0[_i]; cv1[_i] = nv1[_i]; }
        if (wr == 1) PG8_BAR;
    }
    PG8_WAIT_V(0);
    PG8_BAR;
#undef PG8_ROWS
#undef PG8_STAGE_A
#undef PG8_SA
#undef PG8_SB
#undef PG8_STAGE
#undef PG8_LDA
#undef PG8_LDB
#undef PG8_MMA
#undef PG8_CAT
#undef PG8_LD8
#undef PG8_WAIT_V
#undef PG8_WAIT_L
#undef PG8_BAR
#undef PG8_SCHED
}
}

#define XB_TMO      128
#define XB_XCNT(j)  (256  + 64 * (j))
#define XB_XSUB(j)  (1280 + 64 * (j))
#define XB_XGEN(j)  (2304 + 64 * (j))
#define XB_TOP      3328
#define XB_TOPGEN   3392
#define XCD_BAR_WORDS 3456
#define XB_SPIN_CAP (1u << 18)
__device__ __forceinline__ unsigned xb_ld(unsigned* p)              { return __hip_atomic_load(p, __ATOMIC_RELAXED, __HIP_MEMORY_SCOPE_AGENT); }
__device__ __forceinline__ unsigned xb_add(unsigned* p, unsigned v) { return __hip_atomic_fetch_add(p, v, __ATOMIC_RELAXED, __HIP_MEMORY_SCOPE_AGENT); }
__device__ __forceinline__ unsigned xb_xcc_id() { return (unsigned)__builtin_amdgcn_s_getreg((3 << 11) | 20) & 0xFu; }
#define XB_SPIN(cond, bar) do { unsigned _sp = 0; while (cond) { __builtin_amdgcn_s_sleep(1); \
    if ((++_sp & 255u) == 0u) { if (xb_ld(&(bar)[XB_TMO])) break; if (_sp > XB_SPIN_CAP) { atomicAdd(&(bar)[XB_TMO], 1u); break; } } } } while (0)
struct XcdBarrier { unsigned* bar; unsigned x; volatile LAS unsigned* st; };
__device__ __forceinline__ XcdBarrier xcd_barrier_post(unsigned* bar, volatile LAS unsigned* st) {
    XcdBarrier b; b.bar = bar; b.x = xb_xcc_id(); b.st = st;
    if (threadIdx.x == 0) (void)xb_add(&bar[XB_XCNT(b.x)], 1u);
    return b;
}
__device__ __forceinline__ void xcd_barrier_complete(unsigned* bar, unsigned x, unsigned& nloc, unsigned& nx) {
    const unsigned G = gridDim.x * gridDim.y * gridDim.z;
    unsigned sum, cnt, mine, sp = 0u;
    for (;;) {
        sum = 0u; cnt = 0u; mine = 0u;
#pragma unroll
        for (unsigned j = 0; j < 16; ++j) { const unsigned c = xb_ld(&bar[XB_XCNT(j)]); sum += c; cnt += (c > 0u) ? 1u : 0u; mine = (j == x) ? c : mine; }
        if (sum == G) break;
        __builtin_amdgcn_s_sleep(1);
        if ((++sp & 255u) == 0u) { if (xb_ld(&bar[XB_TMO])) break; if (sp > XB_SPIN_CAP) { atomicAdd(&bar[XB_TMO], 1u); break; } }
    }
    nloc = mine > 0u ? mine : 1u; nx = cnt > 0u ? cnt : 1u;
}
__device__ __forceinline__ void xcd_barrier(const XcdBarrier& b) {
    asm volatile("s_waitcnt vmcnt(0)" ::: "memory");
    __syncthreads();
    if (threadIdx.x == 0) {
        unsigned* bar = b.bar;
        __builtin_amdgcn_s_waitcnt(0);
        unsigned nloc = b.st[0], nx = b.st[1];
        if (nloc == 0u) { xcd_barrier_complete(bar, b.x, nloc, nx); b.st[0] = nloc; b.st[1] = nx; }
        const unsigned old = xb_add(&bar[XB_XSUB(b.x)], 1u);
        const unsigned gen = old / nloc;
        if (old + 1u == (gen + 1u) * nloc) {
            __builtin_amdgcn_fence(__ATOMIC_RELEASE, "agent");
            asm volatile("s_waitcnt vmcnt(0)" ::: "memory");
            const unsigned og = xb_add(&bar[XB_TOP], 1u);
            const unsigned tg = og / nx;
            if (og + 1u == (tg + 1u) * nx) xb_add(&bar[XB_TOPGEN], 1u);
            else XB_SPIN(xb_ld(&bar[XB_TOPGEN]) == tg, bar);
            __builtin_amdgcn_fence(__ATOMIC_ACQUIRE, "agent");
            xb_add(&bar[XB_XGEN(b.x)], 1u);
            asm volatile("s_waitcnt vmcnt(0)" ::: "memory");
        } else {
            XB_SPIN(xb_ld(&bar[XB_XGEN(b.x)]) == gen, bar);
            __builtin_amdgcn_fence(__ATOMIC_ACQUIRE, "agent");
            asm volatile("s_waitcnt vmcnt(0)" ::: "memory");
        }
    }
    __syncthreads();
}

struct Ctx { LAS unsigned char* lds; int tid, lane, wave, G, wg; };

__device__ __forceinline__ void tr_item(const float* W, int K, int N, bf16* WT, int drow, int k0, int n0, LAS float* scr, int lane) {
    f32x4 tv[16];
#pragma unroll
    for (int i = 0; i < 16; ++i) tv[i] = *(const f32x4*)(W + (size_t)(k0 + 8 * i + (lane >> 3)) * N + n0 + 4 * (lane & 7));
#pragma unroll
    for (int i = 0; i < 16; ++i) { LAS float* d = scr + (8 * i + (lane >> 3)) * 33 + 4 * (lane & 7); d[0] = tv[i][0]; d[1] = tv[i][1]; d[2] = tv[i][2]; d[3] = tv[i][3]; }
    LDS_WAIT(); asm volatile("" ::: "memory");
#pragma unroll
    for (int j = 0; j < 8; ++j) { const int c = (lane >> 3) + 8 * (j & 1), n = (lane & 7) + 8 * (j >> 1); const LAS float* s = scr + (8 * c) * 33 + n;
        u32x4 o; o.x = cvt_pk_bf16(s[0 * 33], s[1 * 33]); o.y = cvt_pk_bf16(s[2 * 33], s[3 * 33]); o.z = cvt_pk_bf16(s[4 * 33], s[5 * 33]); o.w = cvt_pk_bf16(s[6 * 33], s[7 * 33]);
        st16(WT + (size_t)(drow + n) * K + k0 + 8 * c, o); }
    LDS_WAIT(); asm volatile("" ::: "memory");
}
__device__ __forceinline__ void tr_item8(const float* W, int K, int N, unsigned char* WT, int drow, int k0, int n0, float sc, LAS float* scr, int lane) {
    f32x4 tv[16];
#pragma unroll
    for (int i = 0; i < 16; ++i) tv[i] = *(const f32x4*)(W + (size_t)(k0 + 8 * i + (lane >> 3)) * N + n0 + 4 * (lane & 7));
#pragma unroll
    for (int i = 0; i < 16; ++i) { LAS float* d = scr + (8 * i + (lane >> 3)) * 33 + 4 * (lane & 7); d[0] = tv[i][0]; d[1] = tv[i][1]; d[2] = tv[i][2]; d[3] = tv[i][3]; }
    LDS_WAIT(); asm volatile("" ::: "memory");
    const int c = lane & 7;
#pragma unroll
    for (int j = 0; j < 4; ++j) { const int n = (lane >> 3) + 8 * j; const LAS float* s = scr + (16 * c) * 33 + n;
        u32x4 o; o.x = pk4_fp8(s[0 * 33] * sc, s[1 * 33] * sc, s[2 * 33] * sc, s[3 * 33] * sc); o.y = pk4_fp8(s[4 * 33] * sc, s[5 * 33] * sc, s[6 * 33] * sc, s[7 * 33] * sc);
        o.z = pk4_fp8(s[8 * 33] * sc, s[9 * 33] * sc, s[10 * 33] * sc, s[11 * 33] * sc); o.w = pk4_fp8(s[12 * 33] * sc, s[13 * 33] * sc, s[14 * 33] * sc, s[15 * 33] * sc);
        st16(WT + (size_t)(drow + n) * K + k0 + 16 * c, o); }
    LDS_WAIT(); asm volatile("" ::: "memory");
}
__device__ __forceinline__ int gu_row(int n, int F) { const int up = n >= F, j = up ? n - F : n; return (j >> 7) * 256 + up * 128 + (j & 127); }

struct Ptrs {
    const float* in[24]; float* out; unsigned char* ws; int ph_lo, ph_hi;
};

__device__ __forceinline__ unsigned long long p_prologue(const Ctx& C, const Ptrs& P) {
    unsigned long long pr_sub = 0ull;
    LAS float* scr = (LAS float*)(C.lds + C.wave * 16896);
    const int gw = C.wg * 8 + C.wave, NGW = C.G * 8;
    unsigned char* ws = P.ws;
    constexpr int I1 = 16 * 128, I2 = 4 * 32, I3 = 16 * 64, I4 = 16 * 352, I5 = 44 * 64, I6 = 16 * 128, I7 = 16 * 64, I8 = 8 * 16 * 88, I9 = 8 * 12 * 64;
    constexpr int NITEMS = I1 + I2 + I3 + I4 + I5 + I6 + I7 + I8 + I9;
    for (int it = gw; it < NITEMS; it += NGW) {
        int r = it;
        if (r < I1) { const int kb = r / 128, nb = r % 128; tr_item(P.in[1], DM, EVEN_IN, (bf16*)(ws + WS_WIN0), 32 * nb, 128 * kb, 32 * nb, scr, C.lane); continue; } r -= I1;
        if (r < I2) { const float* pw = P.in[2] + (size_t)r * 2048; const float* sc = P.in[3] + 256 * (r >> 5); bf16* o = (bf16*)(ws + WS_PW) + (size_t)r * 2048;
#pragma unroll
            for (int i = 0; i < 8; ++i) { const f32x4 a = *(const f32x4*)(pw + 256 * i + 4 * C.lane), b = *(const f32x4*)(sc + 4 * C.lane); u32x2 w; w.x = cvt_pk_bf16(a[0] * b[0], a[1] * b[1]); w.y = cvt_pk_bf16(a[2] * b[2], a[3] * b[3]); *(u32x2*)(o + 256 * i + 4 * C.lane) = w; }
            continue; } r -= I2;
        if (r < I3) { const int kb = r / 64, nb = r % 64;
            if (kb < 8) tr_item(P.in[4], 1024, DM, (bf16*)(ws + WS_WTMP), 32 * nb, 128 * kb, 32 * nb, scr, C.lane);
            else tr_item(P.in[4], DM, DM, (bf16*)(ws + WS_WOUT0), 32 * nb, 128 * kb, 32 * nb, scr, C.lane);
            continue; } r -= I3;
        if (r < I4) { const int kb = r / 352, nb = r % 352; tr_item8(P.in[7], DM, 2 * FFN, ws + WS_WGU, gu_row(32 * nb, FFN), 128 * kb, 32 * nb, S8_W1, scr, C.lane); continue; } r -= I4;
        if (r < I5) { const int kb = r / 64, nb = r % 64; tr_item8(P.in[8], FFN, DM, ws + WS_WDN, 32 * nb, 128 * kb, 32 * nb, S8_W2, scr, C.lane); continue; } r -= I5;
        if (r < I6) { const int kb = r / 128, nb = r % 128; tr_item(P.in[11], DM, 4096, (bf16*)(ws + WS_WIN1), 32 * nb, 128 * kb, 32 * nb, scr, C.lane); continue; } r -= I6;
        if (r < I7) { const int kb = r / 64, nb = r % 64; tr_item(P.in[16], DM, DM, (bf16*)(ws + WS_WOUT1), 32 * nb, 128 * kb, 32 * nb, scr, C.lane); continue; } r -= I7;
        if (r < I8) { const int e = r / (16 * 88), q = r % (16 * 88), kb = q / 88, nb = q % 88;
            tr_item8(P.in[20] + (size_t)e * DM * 2 * EDIM, DM, 2 * EDIM, ws + WS_MGU + (size_t)e * 2 * EDIM * DM, gu_row(32 * nb, EDIM), 128 * kb, 32 * nb, S8_W1, scr, C.lane); continue; } r -= I8;
        { const int e = r / (12 * 64), q = r % (12 * 64), kb = q / 64, nb = q % 64; unsigned char* wt = ws + WS_MDN + (size_t)e * DM * EPAD;
            if (kb < 11) tr_item8(P.in[21] + (size_t)e * EDIM * DM, EPAD, DM, wt, 32 * nb, 128 * kb, 32 * nb, S8_W2, scr, C.lane);
            else { const int n = C.lane >> 1, hf = C.lane & 1; const u32x4 z = {0u, 0u, 0u, 0u};
                unsigned char* zp = wt + (size_t)(32 * nb + n) * EPAD + 128 * kb + 64 * hf; st16(zp, z); st16(zp + 16, z); st16(zp + 32, z); st16(zp + 48, z); } }
    }
    if (MK_PROBE_SUB) pr_sub = __builtin_amdgcn_s_memrealtime();
    { unsigned long long* lx = (unsigned long long*)(ws + WS_LNX);
        for (size_t i = (size_t)C.wg * 512 + C.tid; i < (size_t)(3 * 2 * MiB / 8); i += (size_t)C.G * 512) __hip_atomic_store(lx + i, 0ull, __ATOMIC_RELAXED, __HIP_MEMORY_SCOPE_AGENT); }
    const float* x = P.in[0]; bf16* XB = (bf16*)(ws + WS_XB);
    const size_t n8 = (size_t)M * DM / 8, stride = (size_t)C.G * 512;
#pragma unroll 4
    for (size_t i = (size_t)C.wg * 512 + C.tid; i < n8; i += stride) {
        const f32x4 a = *(const f32x4*)(x + i * 8), b = *(const f32x4*)(x + i * 8 + 4);
        u32x4 w; w.x = cvt_pk_bf16(a[0], a[1]); w.y = cvt_pk_bf16(a[2], a[3]); w.z = cvt_pk_bf16(b[0], b[1]); w.w = cvt_pk_bf16(b[2], b[3]);
        st16(XB + i * 8, w);
    }
    __syncthreads();
    for (int u = C.tid; u < 1024; u += 512) ((LAS unsigned*)(C.lds + RING_BYTES))[u] = 0u;
    __syncthreads();
    return pr_sub;
}

template <int W> __device__ __forceinline__ void pooldiff_group(const Ctx& C, const bf16* PROJ, bf16* D, int g) {
    const size_t nitems = (size_t)M * 32, stride = (size_t)C.G * 512;
    for (size_t it = (size_t)C.wg * 512 + C.tid; it < nitems; it += stride) {
        const int row = (int)(it >> 5), c32 = (int)(it & 31), t = row & (SEQ - 1);
        const bf16* p = PROJ + (size_t)row * 4096 + g * 256 + c32 * 8;
        u32x4 v[W];
#pragma unroll
        for (int j = 0; j < W; ++j) { const int jj = j < t ? j : t; v[j] = *(const u32x4*)(p - (size_t)jj * 4096); }
        float s[8] = {bf_lo(v[0].x), bf_hi(v[0].x), bf_lo(v[0].y), bf_hi(v[0].y), bf_lo(v[0].z), bf_hi(v[0].z), bf_lo(v[0].w), bf_hi(v[0].w)};
        float o[8];
#pragma unroll
        for (int k = 0; k < 8; ++k) o[k] = s[k];
#pragma unroll
        for (int j = 1; j < W; ++j) { const float m = (j <= t) ? 1.0f : 0.0f;
            s[0] += m * bf_lo(v[j].x); s[1] += m * bf_hi(v[j].x); s[2] += m * bf_lo(v[j].y); s[3] += m * bf_hi(v[j].y); s[4] += m * bf_lo(v[j].z); s[5] += m * bf_hi(v[j].z); s[6] += m * bf_lo(v[j].w); s[7] += m * bf_hi(v[j].w); }
        const float inv = 1.0f / (float)((t + 1) < W ? (t + 1) : W);
#pragma unroll
        for (int k = 0; k < 8; ++k) o[k] = s[k] * inv - o[k];
        u32x4 wv; wv.x = cvt_pk_bf16(o[0], o[1]); wv.y = cvt_pk_bf16(o[2], o[3]); wv.z = cvt_pk_bf16(o[4], o[5]); wv.w = cvt_pk_bf16(o[6], o[7]);
        st16(D + (size_t)row * DM + g * 256 + c32 * 8, wv);
    }
}
__device__ __forceinline__ void p_pooldiff(const Ctx& C, const bf16* PROJ, bf16* D) {
    pooldiff_group<2>(C, PROJ, D, 0); pooldiff_group<4>(C, PROJ, D, 1); pooldiff_group<8>(C, PROJ, D, 2); pooldiff_group<16>(C, PROJ, D, 3);
}

__device__ __forceinline__ void p_attention(const Ctx& C, const bf16* PROJ, bf16* MIX) {
    constexpr int KP = 136, VP = 68;
    LAS bf16* Ks = (LAS bf16*)C.lds;
    LAS bf16* Vt = (LAS bf16*)(C.lds + 2 * 64 * KP * 2);
    volatile LAS int* flg = (volatile LAS int*)(C.lds + 2 * 64 * KP * 2 + 2 * 128 * VP * 2);
    const int lane = C.lane, w = C.wave, r = lane & 31, h = lane >> 5, tid = C.tid;
    const int rp = 16 * ((r >> 2) & 1) + 4 * (r >> 3) + (r & 3);
    constexpr float SC2 = 0.08838834764831845f * 1.4426950408889634f;
    constexpr float RDONE = 1.0e-37f;
    for (int ui = C.wg; ui < 1024; ui += C.G) {
        const int bh = ui & 15, qb = ui >> 4, b = bh >> 3, hd = bh & 7;
        const size_t rowbase = (size_t)b * SEQ;
        const int tw0 = qb * 256 + w * 32;
        bf16x8 qf[8];
        { const bf16* qp = PROJ + (rowbase + tw0 + r) * 4096 + 1024 + hd * 128 + 8 * h;
#pragma unroll
          for (int st = 0; st < 8; ++st) qf[st] = *(const bf16x8*)(qp + 16 * st); }
        f32x16 O[4];
#pragma unroll
        for (int d = 0; d < 4; ++d)
#pragma unroll
            for (int i = 0; i < 16; ++i) O[d][i] = 0.f;
        float R = 1.0f; bool wdone = false;
        const int kt_hi = qb * 4 + 3;
        u32x4 kreg[2], vreg[2];
#define ATT_LOAD(kt) do { _Pragma("unroll") for (int _i = 0; _i < 2; ++_i) { const int _c = tid + 512 * _i; \
            kreg[_i] = *(const u32x4*)(PROJ + (rowbase + 64 * (kt) + (_c >> 4)) * 4096 + 2048 + hd * 128 + 8 * (_c & 15)); \
            vreg[_i] = *(const u32x4*)(PROJ + (rowbase + 64 * (kt) + lane) * 4096 + 3072 + hd * 128 + 8 * (w + 8 * _i)); } } while (0)
#define ATT_STORE(buf) do { _Pragma("unroll") for (int _i = 0; _i < 2; ++_i) { const int _c = tid + 512 * _i; \
            *(LAS u32x4*)(Ks + (buf) * 64 * KP + (_c >> 4) * KP + 8 * (_c & 15)) = kreg[_i]; \
            LAS bf16* _vp = Vt + (buf) * 128 * VP + (8 * (w + 8 * _i)) * VP + lane; const u32x4 _v = vreg[_i]; \
            _vp[0 * VP] = (bf16)(_v.x & 0xffff); _vp[1 * VP] = (bf16)(_v.x >> 16); _vp[2 * VP] = (bf16)(_v.y & 0xffff); _vp[3 * VP] = (bf16)(_v.y >> 16); \
            _vp[4 * VP] = (bf16)(_v.z & 0xffff); _vp[5 * VP] = (bf16)(_v.z >> 16); _vp[6 * VP] = (bf16)(_v.w & 0xffff); _vp[7 * VP] = (bf16)(_v.w >> 16); } } while (0)
        ATT_LOAD(kt_hi); ATT_STORE(0);
        __syncthreads();
        for (int kt = kt_hi, it = 0; ; --kt, ++it) {
            const int buf = it & 1; const bool more = kt > 0;
            if (more) ATT_LOAD(kt - 1);
            if (!wdone) {
#pragma unroll
                for (int sub = 1; sub >= 0; --sub) {
                    if (64 * kt + 32 * sub <= tw0 + 30) {
                        f32x16 acc;
#pragma unroll
                        for (int i = 0; i < 16; ++i) acc[i] = 0.f;
                        const LAS bf16* kp = Ks + buf * 64 * KP + (32 * sub + r) * KP + 8 * h;
                        bf16x8 kf[8];
#pragma unroll
                        for (int st = 0; st < 8; ++st) kf[st] = *(const LAS bf16x8*)(kp + 16 * st);
                        asm volatile("s_waitcnt lgkmcnt(0)" ::: "memory"); __builtin_amdgcn_sched_barrier(0);
#pragma unroll
                        for (int st = 0; st < 8; ++st) acc = __builtin_amdgcn_mfma_f32_32x32x16_bf16(kf[st], qf[st], acc, 0, 0, 0);
                        __builtin_amdgcn_sched_barrier(0);
                        bf16x8 vf[4][2];
#pragma unroll
                        for (int dt = 0; dt < 4; ++dt)
#pragma unroll
                            for (int s2 = 0; s2 < 2; ++s2) { const LAS bf16* vp = Vt + buf * 128 * VP + (32 * dt + rp) * VP + 32 * sub + 16 * s2 + 4 * h;
                                const bf16x4 lo = *(const LAS bf16x4*)vp, hi = *(const LAS bf16x4*)(vp + 8);
                                vf[dt][s2] = (bf16x8){lo[0], lo[1], lo[2], lo[3], hi[0], hi[1], hi[2], hi[3]}; }
                        __builtin_amdgcn_sched_barrier(0);
                        const int key0 = 64 * kt + 32 * sub + 4 * h, query = tw0 + r;
                        float Q[16], Bt[16];
#pragma unroll
                        for (int i = 0; i < 16; ++i) { const int key = key0 + (i & 3) + 8 * (i >> 2); const bool valid = key < query;
                            const float e = __builtin_amdgcn_exp2f(fminf(acc[i] * SC2, 120.0f)), q = __builtin_amdgcn_rcpf(1.0f + e);
                            Q[i] = valid ? q : 1.0f; Bt[i] = valid ? e * q : 0.0f; }
                        float T[4], PGm[4];
#pragma unroll
                        for (int g = 0; g < 4; ++g) { const float Gs = (Q[4 * g] * Q[4 * g + 1]) * (Q[4 * g + 2] * Q[4 * g + 3]);
                            const auto rr = __builtin_amdgcn_permlane32_swap(__float_as_uint(Gs), __float_as_uint(Gs), false, false);
                            const float lo = __uint_as_float(rr[0]), hi = __uint_as_float(rr[1]);
                            T[g] = lo * hi; PGm[g] = (h == 0) ? hi : 1.0f; }
                        float SG[4]; SG[3] = 1.0f; SG[2] = T[3]; SG[1] = T[3] * T[2]; SG[0] = SG[1] * T[1];
                        const float total = SG[0] * T[0];
                        float a[16];
#pragma unroll
                        for (int g = 0; g < 4; ++g) { const float b3 = R * SG[g] * PGm[g], b2 = b3 * Q[4 * g + 3], b1 = b2 * Q[4 * g + 2], b0 = b1 * Q[4 * g + 1];
                            a[4 * g + 3] = Bt[4 * g + 3] * b3; a[4 * g + 2] = Bt[4 * g + 2] * b2; a[4 * g + 1] = Bt[4 * g + 1] * b1; a[4 * g + 0] = Bt[4 * g + 0] * b0; }
                        R *= total;
                        bf16x8 pb[2];
#pragma unroll
                        for (int s = 0; s < 2; ++s) { u32x4 wv; wv.x = cvt_pk_bf16(a[8 * s + 0], a[8 * s + 1]); wv.y = cvt_pk_bf16(a[8 * s + 2], a[8 * s + 3]); wv.z = cvt_pk_bf16(a[8 * s + 4], a[8 * s + 5]); wv.w = cvt_pk_bf16(a[8 * s + 6], a[8 * s + 7]);
                            pb[s] = __builtin_bit_cast(bf16x8, wv); }
                        asm volatile("s_waitcnt lgkmcnt(0)" ::: "memory"); __builtin_amdgcn_sched_barrier(0);
#pragma unroll
                        for (int dt = 0; dt < 4; ++dt)
#pragma unroll
                            for (int s = 0; s < 2; ++s) O[dt] = __builtin_amdgcn_mfma_f32_32x32x16_bf16(vf[dt][s], pb[s], O[dt], 0, 0, 0);
                        __builtin_amdgcn_sched_barrier(0);
                    }
                }
                wdone = __all(R < RDONE);
            }
            if (more) ATT_STORE(buf ^ 1);
            if (lane == 0) flg[buf * 8 + w] = wdone ? 1 : 0;
            __syncthreads();
            if (!more) break;
            int alld = 1;
#pragma unroll
            for (int j = 0; j < 8; ++j) alld &= flg[buf * 8 + j];
            if (alld) break;
        }
#undef ATT_LOAD
#undef ATT_STORE
        bf16* op = MIX + (rowbase + tw0 + r) * DM + 1024 + hd * 128 + 16 * h;
#pragma unroll
        for (int dt = 0; dt < 4; ++dt)
#pragma unroll
            for (int hv = 0; hv < 2; ++hv) { const int i0 = 8 * hv; u32x4 wv; wv.x = cvt_pk_bf16(O[dt][i0], O[dt][i0 + 1]); wv.y = cvt_pk_bf16(O[dt][i0 + 2], O[dt][i0 + 3]); wv.z = cvt_pk_bf16(O[dt][i0 + 4], O[dt][i0 + 5]); wv.w = cvt_pk_bf16(O[dt][i0 + 6], O[dt][i0 + 7]);
                st16(op + 32 * dt + 8 * hv, wv); }
        __syncthreads();
    }
}

template <bool OUT_F32, bool ROUTE, bool W8 = false, bool PRE = false>
__device__ __forceinline__ void p_layernorm(const Ctx& C, const bf16* Tin, const float* gam, const float* bet, bf16* XBo, float* outf, unsigned char* X8o, const float* wr_, unsigned* cnt, int* list, float* gates, int* ppos = nullptr) {
    LAS float* WrT = (LAS float*)C.lds;
    LAS int* rec = (LAS int*)(C.lds + 65536);
    const int lane = C.lane;
    if (ROUTE) { for (int i = C.tid; i < DM * 8; i += 512) { const int c = i >> 3, e = i & 7; WrT[e * DM + c] = wr_[i]; } __syncthreads(); }
    f32x4 gv[8], bv[8];
#pragma unroll
    for (int j = 0; j < 4; ++j) { if (PRE) { gv[2 * j] = gv[2 * j + 1] = bv[2 * j] = bv[2 * j + 1] = (f32x4){0.f, 0.f, 0.f, 0.f}; continue; }
        gv[2 * j] = *(const f32x4*)(gam + 512 * j + 8 * lane); gv[2 * j + 1] = *(const f32x4*)(gam + 512 * j + 8 * lane + 4);
        bv[2 * j] = *(const f32x4*)(bet + 512 * j + 8 * lane); bv[2 * j + 1] = *(const f32x4*)(bet + 512 * j + 8 * lane + 4); }
    const int rows_per = (M + C.G - 1) / C.G, row_lo = C.wg * rows_per, row_hi = (row_lo + rows_per) < M ? (row_lo + rows_per) : M;
#pragma unroll 2
    for (int row = row_lo + C.wave; row < row_hi; row += 8) {
        const bf16* xr = Tin + (size_t)row * DM + 8 * lane;
        f32x4 v[8]; float s = 0.f;
#pragma unroll
        for (int j = 0; j < 4; ++j) { const u32x4 r = *(const u32x4*)(xr + 512 * j);
            v[2 * j] = (f32x4){bf_lo(r.x), bf_hi(r.x), bf_lo(r.y), bf_hi(r.y)}; v[2 * j + 1] = (f32x4){bf_lo(r.z), bf_hi(r.z), bf_lo(r.w), bf_hi(r.w)}; }
#pragma unroll
        for (int j = 0; j < 8; ++j) s += (v[j][0] + v[j][1]) + (v[j][2] + v[j][3]);
        if (!PRE) {
        const float mean = wave_sum(s) * (1.0f / DM); float q = 0.f;
#pragma unroll
        for (int j = 0; j < 8; ++j) { v[j] = v[j] - mean; q += (v[j][0] * v[j][0] + v[j][1] * v[j][1]) + (v[j][2] * v[j][2] + v[j][3] * v[j][3]); }
        const float rstd = 1.0f / sqrtf(wave_sum(q) * (1.0f / DM) + LN_EPS);
#pragma unroll
        for (int j = 0; j < 8; ++j) v[j] = v[j] * rstd * gv[j] + bv[j];
        }
        if (PRE) {} else if (OUT_F32) { float* o = outf + (size_t)row * DM + 8 * lane;
#pragma unroll
            for (int j = 0; j < 4; ++j) { st16f(o + 512 * j, v[2 * j]); st16f(o + 512 * j + 4, v[2 * j + 1]); } }
        else { bf16* xb = XBo + (size_t)row * DM + 8 * lane;
#pragma unroll
            for (int j = 0; j < 4; ++j) { u32x4 wv; wv.x = cvt_pk_bf16(v[2 * j][0], v[2 * j][1]); wv.y = cvt_pk_bf16(v[2 * j][2], v[2 * j][3]); wv.z = cvt_pk_bf16(v[2 * j + 1][0], v[2 * j + 1][1]); wv.w = cvt_pk_bf16(v[2 * j + 1][2], v[2 * j + 1][3]);
                st16(xb + 512 * j, wv); }
            if (W8) { unsigned char* x8 = X8o + (size_t)row * DM + 8 * lane;
#pragma unroll
                for (int j = 0; j < 4; ++j) { u32x2 wv; wv.x = pk4_fp8(v[2 * j][0] * S8_X, v[2 * j][1] * S8_X, v[2 * j][2] * S8_X, v[2 * j][3] * S8_X); wv.y = pk4_fp8(v[2 * j + 1][0] * S8_X, v[2 * j + 1][1] * S8_X, v[2 * j + 1][2] * S8_X, v[2 * j + 1][3] * S8_X);
                    st8(x8 + 512 * j, wv); } } }
        if (ROUTE) {
            float lg[8];
#pragma unroll
            for (int e = 0; e < 8; ++e) { float a = 0.f;
#pragma unroll
                for (int j = 0; j < 4; ++j) { const f32x4 w0 = *(const LAS f32x4*)(WrT + e * DM + 512 * j + 8 * lane), w1 = *(const LAS f32x4*)(WrT + e * DM + 512 * j + 8 * lane + 4);
                    a += (v[2 * j][0] * w0[0] + v[2 * j][1] * w0[1]) + (v[2 * j][2] * w0[2] + v[2 * j][3] * w0[3]) + (v[2 * j + 1][0] * w1[0] + v[2 * j + 1][1] * w1[1]) + (v[2 * j + 1][2] * w1[2] + v[2 * j + 1][3] * w1[3]); }
                lg[e] = wave_sum(a); }
            int e0 = 0; float v0 = lg[0];
#pragma unroll
            for (int e = 1; e < 8; ++e) if (lg[e] > v0) { v0 = lg[e]; e0 = e; }
            int e1 = -1; float v1 = -3.0e38f;
#pragma unroll
            for (int e = 0; e < 8; ++e) if (e != e0 && lg[e] > v1) { v1 = lg[e]; e1 = e; }
            const float g0 = 1.0f / (1.0f + __expf(v1 - v0)), g1 = 1.0f - g0;
            if (lane == 0) { LAS int* rc = rec + (row - row_lo) * 4; rc[0] = e0; rc[1] = e1; rc[2] = __float_as_int(g0); rc[3] = __float_as_int(g1); }
        }
    }
    if (ROUTE) {
        __syncthreads();
        if (C.tid < 16) {
            const int g = C.tid, slot = g >> 3, e = g & 7, nrow = row_hi - row_lo; int n = 0;
            for (int i = 0; i < nrow; ++i) n += (rec[i * 4 + slot] == e) ? 1 : 0;
            if (n > 0) { int pos = (int)__hip_atomic_fetch_add(cnt + g, (unsigned)n, RLX_AGENT);
                for (int i = 0; i < nrow; ++i) if (rec[i * 4 + slot] == e) { list[g * LISTCAP + pos] = row_lo + i; gates[g * LISTCAP + pos] = __int_as_float(rec[i * 4 + 2 + slot]); ppos[(row_lo + i) * 2 + slot] = (g << 15) | pos; ++pos; } }
        }
        __syncthreads();
    }
}

__device__ __forceinline__ void p_router(const Ctx& C, const bf16* Hin, const float* wr_, unsigned* cnt, int* list, float* gates, int* ppos) {
    constexpr int WPT = 2056;
    LAS bf16* Wh = (LAS bf16*)C.lds; LAS bf16* Wl = Wh + 8 * WPT;
    LAS float* LG = (LAS float*)(C.lds + 2 * 8 * WPT * 2);
    LAS int* rec = (LAS int*)(C.lds + 2 * 8 * WPT * 2 + 4096);
    const int lane = C.lane, w = C.wave, r16 = lane & 15, q = lane >> 4;
    for (int i = C.tid; i < DM * 8; i += 512) { const int c = i >> 3, e = i & 7; const float x = wr_[i]; const unsigned hb = cvt_pk_bf16(x, 0.f) & 0xffff; const float lo = x - __uint_as_float(hb << 16);
        Wh[e * WPT + c] = (bf16)hb; Wl[e * WPT + c] = (bf16)(cvt_pk_bf16(lo, 0.f) & 0xffff); }
    __syncthreads();
    const int rows_per = (M + C.G - 1) / C.G, row_lo = C.wg * rows_per, row_hi = (row_lo + rows_per) < M ? (row_lo + rows_per) : M;
    for (int rb = 0; rb < rows_per; rb += 128) {
        int myrow = row_lo + rb + 16 * w + r16; if (myrow >= row_hi) myrow = row_hi - 1;
        const bf16* ap = Hin + (size_t)myrow * DM + 8 * q; const LAS bf16* bh = Wh + (r16 & 7) * WPT + 8 * q; const LAS bf16* bl = Wl + (r16 & 7) * WPT + 8 * q;
        f32x4 a0 = {0.f, 0.f, 0.f, 0.f}, a1 = {0.f, 0.f, 0.f, 0.f};
        for (int k0 = 0; k0 < 64; k0 += 8) { bf16x8 af[8];
#pragma unroll
            for (int k = 0; k < 8; ++k) af[k] = *(const bf16x8*)(ap + 32 * (k0 + k));
#pragma unroll
            for (int k = 0; k < 8; ++k) { const bf16x8 h8 = *(const LAS bf16x8*)(bh + 32 * (k0 + k)), l8 = *(const LAS bf16x8*)(bl + 32 * (k0 + k));
                a0 = __builtin_amdgcn_mfma_f32_16x16x32_bf16(af[k], h8, a0, 0, 0, 0); a1 = __builtin_amdgcn_mfma_f32_16x16x32_bf16(af[k], l8, a1, 0, 0, 0); } }
        a0 = a0 + a1;
        if (r16 < 8) {
#pragma unroll
            for (int e = 0; e < 4; ++e) LG[(16 * w + 4 * q + e) * 8 + r16] = a0[e]; }
        __syncthreads();
        if (C.tid < 128 && row_lo + rb + C.tid < row_hi) { const f32x4 la = *(const LAS f32x4*)(LG + C.tid * 8), lb = *(const LAS f32x4*)(LG + C.tid * 8 + 4);
            const float lg[8] = {la[0], la[1], la[2], la[3], lb[0], lb[1], lb[2], lb[3]};
            int e0 = 0; float v0 = lg[0];
#pragma unroll
            for (int e = 1; e < 8; ++e) if (lg[e] > v0) { v0 = lg[e]; e0 = e; }
            int e1 = -1; float v1 = -3.0e38f;
#pragma unroll
            for (int e = 0; e < 8; ++e) if (e != e0 && lg[e] > v1) { v1 = lg[e]; e1 = e; }
            const float g0 = 1.0f / (1.0f + __expf(v1 - v0)), g1 = 1.0f - g0;
            LAS int* rc = rec + (rb + C.tid) * 4; rc[0] = e0; rc[1] = e1; rc[2] = __float_as_int(g0); rc[3] = __float_as_int(g1); }
        __syncthreads();
    }
    if (rows_per == 128 && row_hi - row_lo == 128) {
        LAS int* cw = rec + 4 * 128;
        int gid[2] = {0, 0}, rk[2] = {0, 0}; float gt[2] = {0.f, 0.f};
        if (C.tid < 128) { const LAS int* rc = rec + C.tid * 4; gid[0] = rc[0]; gid[1] = 8 + rc[1]; gt[0] = __int_as_float(rc[2]); gt[1] = __int_as_float(rc[3]);
            const unsigned long long below = (1ull << lane) - 1ull;
#pragma unroll
            for (int g = 0; g < 16; ++g) { const unsigned long long m = __ballot(gid[g >> 3] == g);
                if (gid[g >> 3] == g) rk[g >> 3] = __popcll(m & below);
                if (lane == 0) cw[w * 16 + g] = __popcll(m); } }
        __syncthreads();
        if (C.tid < 16) { const int n0 = cw[C.tid], n1 = cw[16 + C.tid]; const int n = n0 + n1;
            cw[32 + C.tid] = n > 0 ? (int)__hip_atomic_fetch_add(cnt + C.tid, (unsigned)n, RLX_AGENT) : 0; }
        __syncthreads();
        if (C.tid < 128) {
#pragma unroll
            for (int sl = 0; sl < 2; ++sl) { const int g = gid[sl], pos = cw[32 + g] + (w == 1 ? cw[g] : 0) + rk[sl];
                list[g * LISTCAP + pos] = row_lo + C.tid; gates[g * LISTCAP + pos] = gt[sl]; ppos[(row_lo + C.tid) * 2 + sl] = (g << 15) | pos; } }
    } else if (C.tid < 16) {
        const int g = C.tid, slot = g >> 3, e = g & 7, nrow = row_hi - row_lo; int n = 0;
        for (int i = 0; i < nrow; ++i) n += (rec[i * 4 + slot] == e) ? 1 : 0;
        if (n > 0) { int pos = (int)__hip_atomic_fetch_add(cnt + g, (unsigned)n, RLX_AGENT);
            for (int i = 0; i < nrow; ++i) if (rec[i * 4 + slot] == e) { list[g * LISTCAP + pos] = row_lo + i; gates[g * LISTCAP + pos] = __int_as_float(rec[i * 4 + 2 + slot]); ppos[(row_lo + i) * 2 + slot] = (g << 15) | pos; ++pos; } }
    }
    __syncthreads();
}

__device__ __forceinline__ void p_final_ln(const Ctx& C, const bf16* XBi, const bf16* OP, const int* ppos, const float* gam, const float* bet, float* outf) {
    const LAS int* tbase = (const LAS int*)(C.lds + TAB_OFF);
    const int lane = C.lane;
    f32x4 gv[8], bv[8];
#pragma unroll
    for (int j = 0; j < 4; ++j) { gv[2 * j] = *(const f32x4*)(gam + 512 * j + 8 * lane); gv[2 * j + 1] = *(const f32x4*)(gam + 512 * j + 8 * lane + 4);
        bv[2 * j] = *(const f32x4*)(bet + 512 * j + 8 * lane); bv[2 * j + 1] = *(const f32x4*)(bet + 512 * j + 8 * lane + 4); }
    const int rows_per = (M + C.G - 1) / C.G, row_lo = C.wg * rows_per, row_hi = (row_lo + rows_per) < M ? (row_lo + rows_per) : M;
    for (int row = row_lo + C.wave; row < row_hi; row += 8) {
        const int p0 = ppos[row * 2], p1 = ppos[row * 2 + 1];
        const size_t r0 = (size_t)(tbase[p0 >> 15] + (p0 & 32767)), r1 = (size_t)(tbase[p1 >> 15] + (p1 & 32767));
        const bf16* xr = XBi + (size_t)row * DM + 8 * lane; const bf16* o0 = OP + r0 * DM + 8 * lane; const bf16* o1 = OP + r1 * DM + 8 * lane;
        u32x4 a[4], b[4], c[4];
#pragma unroll
        for (int j = 0; j < 4; ++j) { a[j] = *(const u32x4*)(xr + 512 * j); b[j] = *(const u32x4*)(o0 + 512 * j); c[j] = *(const u32x4*)(o1 + 512 * j); }
        f32x4 v[8]; float s = 0.f;
#pragma unroll
        for (int j = 0; j < 4; ++j) {
            v[2 * j] = (f32x4){bf_lo(a[j].x), bf_hi(a[j].x), bf_lo(a[j].y), bf_hi(a[j].y)} * DN_ALPHA + ((f32x4){bf_lo(b[j].x), bf_hi(b[j].x), bf_lo(b[j].y), bf_hi(b[j].y)} + (f32x4){bf_lo(c[j].x), bf_hi(c[j].x), bf_lo(c[j].y), bf_hi(c[j].y)});
            v[2 * j + 1] = (f32x4){bf_lo(a[j].z), bf_hi(a[j].z), bf_lo(a[j].w), bf_hi(a[j].w)} * DN_ALPHA + ((f32x4){bf_lo(b[j].z), bf_hi(b[j].z), bf_lo(b[j].w), bf_hi(b[j].w)} + (f32x4){bf_lo(c[j].z), bf_hi(c[j].z), bf_lo(c[j].w), bf_hi(c[j].w)}); }
#pragma unroll
        for (int j = 0; j < 8; ++j) s += (v[j][0] + v[j][1]) + (v[j][2] + v[j][3]);
        const float mean = wave_sum(s) * (1.0f / DM); float q = 0.f;
#pragma unroll
        for (int j = 0; j < 8; ++j) { v[j] = v[j] - mean; q += (v[j][0] * v[j][0] + v[j][1] * v[j][1]) + (v[j][2] * v[j][2] + v[j][3] * v[j][3]); }
        const float rstd = 1.0f / sqrtf(wave_sum(q) * (1.0f / DM) + LN_EPS);
        float* o = outf + (size_t)row * DM + 8 * lane;
#pragma unroll
        for (int j = 0; j < 4; ++j) { st16f(o + 512 * j, v[2 * j] * rstd * gv[2 * j] + bv[2 * j]); st16f(o + 512 * j + 4, v[2 * j + 1] * rstd * gv[2 * j + 1] + bv[2 * j + 1]); }
    }
}

__device__ __forceinline__ void p_sgu(const Ctx& C, const bf16* Z, bf16* SGo, const f32x2* vst, const float* sw, const float* sb, const float* lng, const float* lnb) {
    constexpr int WP = 136, NB = 16;
    LAS bf16* Ws = (LAS bf16*)C.lds;
    LAS bf16* vnT = (LAS bf16*)(C.lds + 128 * WP * 2);
    LAS f32x2* musr = (LAS f32x2*)(C.lds + 128 * WP * 2 + 256 * WP * 2);
    LAS float* bs = (LAS float*)(musr + NB * 128); LAS float* gm = bs + 128; LAS float* bt = gm + 256;
    const int lane = C.lane, w = C.wave, r = lane & 31, h = lane >> 5, tid = C.tid;
    const int rp = 16 * ((r >> 2) & 1) + 4 * (r >> 3) + (r & 3);
    const int sV = (lane & 31) + 32 * (w & 3), cV = (lane >> 5) + 2 * (w >> 2);
    int cur_g = -1;
    for (int ub = C.wg; ub < 2048; ub += NB * C.G) {
        int nb = (2048 - ub + C.G - 1) / C.G; if (nb > NB) nb = NB;
        __syncthreads();
        for (int idx = tid; idx < nb * 128; idx += 512) { const int u = ub + (idx >> 7) * C.G; const f32x2* p = vst + ((size_t)(u >> 3) * 128 + (idx & 127)) * 32; float s1 = 0.f, s2 = 0.f;
#pragma unroll 8
            for (int j = 0; j < 32; ++j) { const f32x2 x = p[j]; s1 += x[0]; s2 += x[1]; }
            const float mean = s1 * (1.0f / 2048.f), var = fmaxf(s2 * (1.0f / 2048.f) - mean * mean, 0.f);
            musr[idx] = (f32x2){mean, 1.0f / sqrtf(var + LN_EPS)}; }
        u32x4 vreg[8];
        { const int g0 = ub & 7; const size_t row0 = (size_t)(ub >> 3) * 128;
#pragma unroll
          for (int i = 0; i < 8; ++i) vreg[i] = *(const u32x4*)(Z + (row0 + sV) * 4096 + 2048 + g0 * 256 + 8 * (cV + 4 * i)); }
        for (int bi = 0; bi < nb; ++bi) {
            const int u = ub + bi * C.G, g = u & 7; const size_t row0 = (size_t)(u >> 3) * 128;
            if (g != cur_g) { cur_g = g; __syncthreads();
                for (int i = tid; i < 128 * 128; i += 512) { const int t = i >> 7, s2_ = i & 127; const float x = sw[(size_t)g * 16384 + i]; Ws[t * WP + s2_] = (bf16)(cvt_pk_bf16(s2_ <= t ? x : 0.f, 0.f) & 0xffff); }
                if (tid < 128) bs[tid] = sb[g * 128 + tid];
                if (tid < 256) { gm[tid] = lng[g * 256 + tid]; bt[tid] = lnb[g * 256 + tid]; }
                __syncthreads(); }
            u32x4 ureg[4][2];
#pragma unroll
            for (int tt = 0; tt < 4; ++tt) { const bf16* up = Z + (row0 + 32 * tt + r) * 4096 + g * 256 + 32 * w + 16 * h; asm volatile("" : "+v"(up));
                ureg[tt][0] = *(const u32x4*)up; ureg[tt][1] = *(const u32x4*)(up + 8); }
            { const f32x2 ms = musr[bi * 128 + sV];
              const LAS float* gmp = gm + 8 * cV; const LAS float* btp = bt + 8 * cV; LAS bf16* dstb = vnT + (8 * cV) * WP + sV;
              asm volatile("" : "+v"(gmp), "+v"(btp), "+v"(dstb));
#pragma unroll
              for (int i = 0; i < 8; ++i) { const u32x4 v = vreg[i];
                float x[8] = {bf_lo(v.x), bf_hi(v.x), bf_lo(v.y), bf_hi(v.y), bf_lo(v.z), bf_hi(v.z), bf_lo(v.w), bf_hi(v.w)};
#pragma unroll
                for (int e = 0; e < 8; ++e) { const float y = (x[e] - ms[0]) * ms[1] * gmp[32 * i + e] + btp[32 * i + e]; dstb[(32 * i + e) * WP] = (bf16)(cvt_pk_bf16(y, 0.f) & 0xffff); }
                asm volatile("" ::: "memory"); } }
            if (bi + 1 < nb) { const int un = u + C.G, gn = un & 7; const size_t rown = (size_t)(un >> 3) * 128; const bf16* vp = Z + (rown + sV) * 4096 + 2048 + gn * 256 + 8 * cV; asm volatile("" : "+v"(vp));
#pragma unroll
                for (int i = 0; i < 8; ++i) vreg[i] = *(const u32x4*)(vp + 32 * i); }
            __syncthreads();
            f32x16 acc[4];
#pragma unroll
            for (int tt = 0; tt < 4; ++tt)
#pragma unroll
                for (int i = 0; i < 16; ++i) acc[tt][i] = 0.f;
#pragma unroll
            for (int ks = 0; ks < 8; ++ks) { const bf16x8 af = *(const LAS bf16x8*)(vnT + (32 * w + rp) * WP + 16 * ks + 8 * h);
#pragma unroll
                for (int tt = 0; tt < 4; ++tt) if (ks <= 2 * tt + 1) { const bf16x8 bfr = *(const LAS bf16x8*)(Ws + (32 * tt + r) * WP + 16 * ks + 8 * h);
                    acc[tt] = __builtin_amdgcn_mfma_f32_32x32x16_bf16(af, bfr, acc[tt], 0, 0, 0); }
                asm volatile("" ::: "memory"); }
            __syncthreads();
#pragma unroll
            for (int tt = 0; tt < 4; ++tt) { const int t = 32 * tt + r; const float bb = bs[t]; bf16* op = SGo + (row0 + t) * DM + g * 256 + 32 * w + 16 * h; asm volatile("" : "+v"(op));
#pragma unroll
                for (int hv = 0; hv < 2; ++hv) { const u32x4 uv = ureg[tt][hv]; const int i0 = 8 * hv;
                    u32x4 wv; wv.x = cvt_pk_bf16(bf_lo(uv.x) * (acc[tt][i0] + bb), bf_hi(uv.x) * (acc[tt][i0 + 1] + bb)); wv.y = cvt_pk_bf16(bf_lo(uv.y) * (acc[tt][i0 + 2] + bb), bf_hi(uv.y) * (acc[tt][i0 + 3] + bb));
                    wv.z = cvt_pk_bf16(bf_lo(uv.z) * (acc[tt][i0 + 4] + bb), bf_hi(uv.z) * (acc[tt][i0 + 5] + bb)); wv.w = cvt_pk_bf16(bf_lo(uv.w) * (acc[tt][i0 + 6] + bb), bf_hi(uv.w) * (acc[tt][i0 + 7] + bb));
                    st16(op + 8 * hv, wv); } }
        }
    }
    __syncthreads();
}

__device__ __forceinline__ void moe_tables(const Ctx& C, const unsigned* cnt) {
    LAS int* tbase = (LAS int*)(C.lds + TAB_OFF); LAS int* tcnt = tbase + 17; LAS unsigned char* tileg = (LAS unsigned char*)(tcnt + 16);
    __syncthreads();
    if (C.tid < 16) { int c = (int)__hip_atomic_load(cnt + C.tid, RLX_AGENT); if (c > LISTCAP) c = LISTCAP; tcnt[C.tid] = c; }
    __syncthreads();
    if (C.tid == 0) { int base = 0;
        for (int g = 0; g < 16; ++g) { tbase[g] = base; base += ((tcnt[g] + 255) >> 8) << 8; }
        tbase[16] = base; }
    __syncthreads();
    for (int t = C.tid; t < (tbase[16] >> 8); t += 512) { int g = 0;
#pragma unroll
        for (int k = 1; k < 16; ++k) g += (t * 256 >= tbase[k]) ? 1 : 0;
        tileg[t] = (unsigned char)g; }
    __syncthreads();
}

__global__ void __launch_bounds__(512, 2) fwd_kernel(Ptrs P) {
    extern __shared__ __attribute__((aligned(16))) unsigned char lds_raw[];
    Ctx C; C.lds = (LAS unsigned char*)lds_raw; C.tid = threadIdx.x; C.lane = C.tid & 63; C.wave = __builtin_amdgcn_readfirstlane(C.tid >> 6); C.G = gridDim.x; C.wg = blockIdx.x;
    unsigned char* ws = P.ws;
    unsigned* ctl = (unsigned*)(ws + WS_CTL);
    for (int u = C.tid; u < (LDS_BYTES - RING_BYTES) / 4; u += 512) ((LAS unsigned*)(C.lds + RING_BYTES))[u] = 0u;
    __syncthreads();
    XcdBarrier bar; bar.bar = ctl + CW_BAR; bar.x = 0; bar.st = nullptr;
    if (!MK_PER_PHASE) bar = xcd_barrier_post(ctl + CW_BAR, (volatile LAS unsigned*)(C.lds + MISC_OFF) + 8);
    const int lo = P.ph_lo, hi = P.ph_hi;
#ifndef PH_MASK
#define PH_MASK 0x1ffff
#endif
#define IN(k) (((PH_MASK >> (k)) & 1) && lo <= (k) && (k) < hi)
#ifndef REP_MASK
#define REP_MASK 0
#endif
#define REP(k) (1 + ((REP_MASK >> (k)) & 1))
#define SEAM(k) do { if (IN(k) && IN((k) + 1)) xcd_barrier(bar); if (MK_PROBE_HI >= 0 && (k) + 1 == MK_PROBE_LO) pr_t0 = __builtin_amdgcn_s_memrealtime(); if (MK_PROBE_HI >= 0 && (k) == MK_PROBE_HI) pr_t1 = __builtin_amdgcn_s_memrealtime(); } while (0)
    unsigned long long pr_t0 = (MK_PROBE_HI >= 0) ? __builtin_amdgcn_s_memrealtime() : 0ull, pr_t1 = 0ull;
#define XB ((bf16*)(ws + WS_XB))
#define TB ((bf16*)(ws + WS_TB))
#define OUT (P.out)
#define PROJ ((bf16*)(ws + WS_PROJ))
#define MIX ((bf16*)(ws + WS_MIX))
#define HID ((bf16*)(ws + WS_HID))
#define Zb ((bf16*)(ws + WS_Z))
#define SGb ((bf16*)(ws + WS_SG))
#define MHID ((bf16*)(ws + WS_MHID))
#define Dd ((bf16*)(ws + WS_D))
#define VST ((f32x2*)(ws + WS_VST))
#define LIST ((int*)(ws + WS_LIST))
#define GATE ((float*)(ws + WS_GATE))
#define CNT (ctl + CW_CNT)
    const LAS int* tbase = (const LAS int*)(C.lds + TAB_OFF); const LAS int* tcnt = tbase + 17; const LAS unsigned char* tileg = (const LAS unsigned char*)(tcnt + 16);

    if (IN(0)) for (int rep_ = 0; rep_ < REP(0); ++rep_) { const unsigned long long ps_ = p_prologue(C, P); if (MK_PROBE_SUB) pr_t1 = ps_; }
    if (!MK_PER_PHASE && IN(0) && IN(1) && C.wave == 0) { unsigned c_ = 0u, sp_ = 0u;
        for (;;) { c_ = (C.lane < 16) ? xb_ld(&bar.bar[XB_XCNT(C.lane)]) : 0u; unsigned s_ = c_;
#pragma unroll
            for (int o = 1; o < 16; o <<= 1) s_ += __shfl_xor(s_, o);
            if ((unsigned)__builtin_amdgcn_readfirstlane((int)s_) == gridDim.x) break;
            if (++sp_ > 4096u) break; __builtin_amdgcn_s_sleep(4); }
        if (sp_ <= 4096u) { const unsigned nx_ = (unsigned)__popcll(__ballot(c_ > 0u)), mine_ = (unsigned)__builtin_amdgcn_readlane((int)c_, (int)bar.x);
            if (C.lane == 0 && mine_ > 0u && nx_ > 0u) { bar.st[0] = mine_; bar.st[1] = nx_; } } }
    SEAM(0);
    if (IN(1)) for (int rep_ = 0; rep_ < REP(1); ++rep_) { pg8::Gemm g{XB, (const bf16*)(ws + WS_WIN0), DM, DM}; pg8::StaticOrder S; S.init(M, EVEN_IN, C.G, C.wg); pg8::EpiBf16 E{PROJ, 4096};
        pg8::gemm_phase<pg8::EpiBf16, pg8::StaticOrder, false>(C.lds, g, S, E);
        int k256 = 256; asm volatile("" : "+s"(k256)); pg8::Gemm gf{(const bf16*)(ws + WS_WTMP), (const bf16*)(ws + WS_PW), k256, 1024}; pg8::FoldOrder Sf{C.wg}; pg8::EpiBf16 Ef{(bf16*)(ws + WS_WOUT0), DM};
        pg8::gemm_phase<pg8::EpiBf16, pg8::FoldOrder, false>(C.lds, gf, Sf, Ef); } SEAM(1);
    if (IN(2)) { for (int rep = 0; rep < REP(2); ++rep) { p_pooldiff(C, PROJ, MIX); p_attention(C, PROJ, MIX); } } SEAM(2);
    const bool fuse_ln = (!MK_PER_PHASE) && C.G == 256;
    if (IN(4)) { pg8::Gemm g{MIX, (const bf16*)(ws + WS_WOUT0), DM, DM};
        if (fuse_ln) { pg8::PanelOrder S{C.wg}; pg8::EpiResLn E{XB, XB, 1.0f, P.in[5], P.in[6], (unsigned long long*)(ws + WS_LNX), ctl + CW_PAN, C.lds + LNX_OFF, ws + WS_X8};
            pg8::gemm_phase<pg8::EpiResLn, pg8::PanelOrder, false>(C.lds, g, S, E); }
        else { pg8::StaticOrder S; S.init(M, DM, C.G, C.wg); pg8::EpiRes E{XB, TB, 1.0f};
            pg8::gemm_phase<pg8::EpiRes, pg8::StaticOrder, false>(C.lds, g, S, E); } } SEAM(4);
    if (IN(5) && !fuse_ln) { p_layernorm<false, false, true>(C, TB, P.in[5], P.in[6], XB, nullptr, ws + WS_X8, nullptr, nullptr, nullptr, nullptr); }
    if (!fuse_ln) SEAM(5);
    if (IN(6)) { pg8::Gemm g{(const bf16*)(ws + WS_X8), (const bf16*)(ws + WS_WGU), DM, DM}; pg8::StaticOrder S; S.init(M, 2 * FFN, C.G, C.wg); pg8::EpiSwiglu8 E{ws + WS_HID, FFN, 44, 1.0f / (S8_X * S8_W1), 0};
        pg8::gemm_phase<pg8::EpiSwiglu8, pg8::StaticOrder, false, true>(C.lds, g, S, E); } SEAM(6);
    if (IN(7)) { pg8::Gemm g{(const bf16*)(ws + WS_HID), (const bf16*)(ws + WS_WDN), FFN, FFN};
        if (fuse_ln) { pg8::PanelOrder S{C.wg}; pg8::EpiResLn E{XB, XB, 1.0f / (S8_H * S8_W2), P.in[9], P.in[10], (unsigned long long*)(ws + WS_LNX) + 262144, ctl + CW_PAN + 8192, C.lds + LNX_OFF, nullptr};
            pg8::gemm_phase<pg8::EpiResLn, pg8::PanelOrder, false, true>(C.lds, g, S, E); }
        else { pg8::StaticOrder S; S.init(M, DM, C.G, C.wg); pg8::EpiRes E{XB, TB, 1.0f / (S8_H * S8_W2)};
            pg8::gemm_phase<pg8::EpiRes, pg8::StaticOrder, false, true>(C.lds, g, S, E); } } SEAM(7);
    if (IN(8) && !fuse_ln) { p_layernorm<false, false>(C, TB, P.in[9], P.in[10], XB, nullptr, nullptr, nullptr, nullptr, nullptr, nullptr); }
    if (!fuse_ln) SEAM(8);
    if (IN(9)) for (int rep_ = 0; rep_ < REP(9); ++rep_) { pg8::Gemm g{XB, (const bf16*)(ws + WS_WIN1), DM, DM}; pg8::StaticOrder S; S.init(M, 4096, C.G, C.wg); pg8::EpiGeluStats E{Zb, VST};
        pg8::gemm_phase<pg8::EpiGeluStats, pg8::StaticOrder, false>(C.lds, g, S, E); } SEAM(9);
    if (IN(10)) { for (int rep = 0; rep < REP(10); ++rep) p_sgu(C, Zb, SGb, VST, P.in[14], P.in[15], P.in[12], P.in[13]); } SEAM(10);
    if (IN(11)) { pg8::Gemm g{SGb, (const bf16*)(ws + WS_WOUT1), DM, DM};
        if (fuse_ln) { pg8::PanelOrder S{C.wg}; pg8::EpiResLn E{XB, XB, 1.0f, P.in[17], P.in[18], (unsigned long long*)(ws + WS_LNX) + 2 * 262144, ctl + CW_PAN + 2 * 8192, C.lds + LNX_OFF, ws + WS_X8};
            pg8::gemm_phase<pg8::EpiResLn, pg8::PanelOrder, false>(C.lds, g, S, E); }
        else { pg8::StaticOrder S; S.init(M, DM, C.G, C.wg); pg8::EpiRes E{XB, TB, 1.0f};
            pg8::gemm_phase<pg8::EpiRes, pg8::StaticOrder, false>(C.lds, g, S, E); } } SEAM(11);
    if (IN(12)) { if (fuse_ln) p_router(C, XB, P.in[19], CNT, LIST, GATE, (int*)(ws + WS_PPOS));
        else p_layernorm<false, true, true>(C, TB, P.in[17], P.in[18], XB, nullptr, ws + WS_X8, P.in[19], CNT, LIST, GATE, (int*)(ws + WS_PPOS)); } SEAM(12);
    if (IN(13)) for (int rep_ = 0; rep_ < REP(13); ++rep_) { moe_tables(C, CNT);
        pg8::Gemm g{(const bf16*)(ws + WS_X8), (const bf16*)(ws + WS_MGU), DM, DM}; pg8::MoeOrder S; S.rep = REP(17); S.nM = tbase[16] >> 8; S.nN = 11; S.nwg = S.nM * 11; S.G = C.G; S.c = C.wg; S.tile0 = 0; S.tbase = tbase; S.tcnt = tcnt; S.tileg = tileg; S.list = LIST;
        pg8::EpiSwiglu8 E{ws + WS_MHID, EPAD, 11, 1.0f / (S8_X * S8_W1), 1};
        LAS int* rt = (LAS int*)(C.lds + LNX_OFF); S.rowtab = rt; const int nmine = C.wg < S.nwg * S.rep ? (S.nwg * S.rep - C.wg + C.G - 1) / C.G : 0;
        for (int base = 0; base < nmine; base += 12) { S.i0 = base; S.ilim = (nmine - base) < 12 ? (nmine - base) : 12;
            int tok[6]; int tid_o = C.tid; asm volatile("" : "+v"(tid_o));
#pragma unroll
            for (int k = 0; k < 6; ++k) { const int j = 2 * k + (C.wave >> 2); pg8::Unit u; (void)S.next(j < S.ilim ? j : 0, u); tok[k] = S.a_row_g(u, C.tid & 255); }
#pragma unroll
            for (int k = 0; k < 6; ++k) { const int idx = tid_o + 512 * k; if (idx < S.ilim * 256) rt[idx] = tok[k]; }
            __syncthreads();
            pg8::gemm_phase<pg8::EpiSwiglu8, pg8::MoeOrder, true, true>(C.lds, g, S, E); } } SEAM(13);
    if (IN(14)) { moe_tables(C, CNT);
        pg8::Gemm g{MHID, (const bf16*)(ws + WS_MDN), EPAD, EPAD}; pg8::MoeOrder S; S.rep = 1; S.nM = tbase[16] >> 8; S.nN = 8; S.nwg = S.nM * 8; S.G = C.G; S.c = C.wg; S.tile0 = 0; S.tbase = tbase; S.tcnt = tcnt; S.tileg = tileg; S.list = LIST; S.rowtab = nullptr; S.i0 = 0; S.ilim = 1 << 30;
        LAS float* gt = (LAS float*)(C.lds + LNX_OFF); const int nmine = C.wg < S.nwg ? (S.nwg - C.wg + C.G - 1) / C.G : 0;
        pg8::EpiMoePairs E{(bf16*)(ws + WS_OPAIR), gt, 1.0f / (S8_H * S8_W2), tbase, tcnt, tileg};
        for (int base = 0; base < nmine; base += 12) { S.i0 = base; S.ilim = (nmine - base) < 12 ? (nmine - base) : 12;
            float gv[6]; int tid_o = C.tid; asm volatile("" : "+v"(tid_o));
#pragma unroll
            for (int k = 0; k < 6; ++k) { const int j = 2 * k + (C.wave >> 2); pg8::Unit u; (void)S.next(j < S.ilim ? j : 0, u);
                const int gq = tileg[u.pm], pos = u.pm * 256 + (C.tid & 255) - tbase[gq], cq = tcnt[gq]; gv[k] = GATE[gq * LISTCAP + (pos < cq ? pos : cq - 1)]; }
#pragma unroll
            for (int k = 0; k < 6; ++k) { const int idx = tid_o + 512 * k; if (idx < S.ilim * 256) gt[idx] = gv[k]; }
            __syncthreads();
            pg8::gemm_phase<pg8::EpiMoePairs, pg8::MoeOrder, false, true>(C.lds, g, S, E); } } SEAM(14);
    if (IN(16)) { moe_tables(C, CNT); p_final_ln(C, XB, (const bf16*)(ws + WS_OPAIR), (const int*)(ws + WS_PPOS), P.in[22], P.in[23], OUT); }
    if (MK_PROBE_HI >= 0) { if (MK_PROBE_HI == 16) pr_t1 = __builtin_amdgcn_s_memrealtime();
        if (C.wg == 0 && C.tid == 0) { const unsigned long long until = __builtin_amdgcn_s_memrealtime() + (unsigned long long)MK_PROBE_AMP * (pr_t1 - pr_t0);
            while (__builtin_amdgcn_s_memrealtime() < until) __builtin_amdgcn_s_sleep(32); } }
#undef IN
#undef SEAM
}

extern "C" void kernel_launch(void* const* d_in, const int* in_sizes, int n_in, void* d_out, int out_size, void* d_ws, size_t ws_size, hipStream_t stream) {
    static int grid = 0;
    if (grid == 0) {
        if (n_in != 24 || in_sizes[0] != M * DM || out_size != M * DM || ws_size < WS_END) { fprintf(stderr, "kernel_launch: unexpected problem (n_in %d, in0 %d, out %d, ws %zu); nothing launched\n", n_in, n_in > 0 ? in_sizes[0] : -1, out_size, ws_size); grid = -1; return; }
        int dev = 0, cus = 0, per_cu = 0;
        if (hipGetDevice(&dev) != hipSuccess || hipDeviceGetAttribute(&cus, hipDeviceAttributeMultiprocessorCount, dev) != hipSuccess) { grid = -1; return; }
        if (hipFuncSetAttribute((const void*)fwd_kernel, hipFuncAttributeMaxDynamicSharedMemorySize, LDS_BYTES) != hipSuccess) { fprintf(stderr, "kernel_launch: hipFuncSetAttribute failed\n"); grid = -1; return; }
        if (hipOccupancyMaxActiveBlocksPerMultiprocessor(&per_cu, (const void*)fwd_kernel, 512, LDS_BYTES) != hipSuccess || per_cu < 1) { fprintf(stderr, "kernel_launch: occupancy query reports %d\n", per_cu); }
        (void)hipGetLastError();
        grid = cus;
    }
    if (grid < 0) return;
    if (hipMemsetAsync((char*)d_ws + WS_CTL, 0, CTL_ZERO_BYTES, stream) != hipSuccess) return;
    Ptrs p{};
    for (int i = 0; i < 24; ++i) p.in[i] = (const float*)d_in[i];
    p.out = (float*)d_out; p.ws = (unsigned char*)d_ws;
#if MK_PER_PHASE
    for (int k = 0; k < NPHASE; ++k) { p.ph_lo = k; p.ph_hi = k + 1; hipLaunchKernelGGL(fwd_kernel, dim3(grid), dim3(512), LDS_BYTES, stream, p); }
#else
    p.ph_lo = 0; p.ph_hi = NPHASE;
    hipLaunchKernelGGL(fwd_kernel, dim3(grid), dim3(512), LDS_BYTES, stream, p);
#endif
}
```

```cpp
#include <hip/hip_runtime.h>
#include <cstdio>
#include <cstdint>

#define LAS __attribute__((address_space(3)))
#define GAS __attribute__((address_space(1)))
typedef unsigned short bf16;
typedef short bf16x8 __attribute__((ext_vector_type(8)));
typedef short bf16x4 __attribute__((ext_vector_type(4)));
typedef float f32x4 __attribute__((ext_vector_type(4)));
typedef float f32x2 __attribute__((ext_vector_type(2)));
typedef float f32x16 __attribute__((ext_vector_type(16)));
typedef unsigned u32x4 __attribute__((ext_vector_type(4)));
typedef unsigned u32x2 __attribute__((ext_vector_type(2)));
typedef int i32x8 __attribute__((ext_vector_type(8)));

#define MK_PROBE_LO 0
#define MK_PROBE_HI -1
#define MK_PROBE_AMP 16
#define MK_PROBE_EPI 0
#define MK_PROBE_SUB 0
#ifndef MK_PER_PHASE
#define MK_PER_PHASE 0
#endif

constexpr int BATCH = 2, SEQ = 16384, DM = 2048, M = BATCH * SEQ;
constexpr int EVEN_IN = 4096, POOLW = 1024, FFN = 5632, NEXP = 8, EDIM = 1408;
constexpr float LN_EPS = 1e-5f, DN_ALPHA = 1.41421356237309515f;
constexpr int NPHASE = 17;
constexpr int EPAD = 1536;
constexpr int LISTCAP = 32768;
constexpr int MOE_ROWS = 2 * M + 16 * 256;

constexpr size_t MiB = 1u << 20;
constexpr size_t WS_CTL = 0, CTL_ZERO_BYTES = 163840;
constexpr size_t WS_WIN0 = 2 * MiB, WS_WOUT0 = 18 * MiB, WS_WGU = 26 * MiB, WS_WDN = 70 * MiB, WS_WIN1 = 92 * MiB, WS_WOUT1 = 108 * MiB, WS_MGU = 116 * MiB, WS_MDN = 204 * MiB, WS_PW = 248 * MiB;
constexpr size_t WS_XB = 250 * MiB;
constexpr size_t WS_TB = 378 * MiB;
constexpr size_t WS_R = 634 * MiB;
constexpr size_t WS_MISC = 1018 * MiB;
constexpr size_t WS_END = 1024 * MiB;
constexpr size_t WS_PROJ = WS_R, WS_MIX = WS_R + 256 * MiB, WS_HID = WS_R, WS_Z = WS_R, WS_SG = WS_R + 256 * MiB, WS_MHID = WS_R;
constexpr size_t WS_D = WS_TB + 128 * MiB, WS_VST = WS_TB + 192 * MiB, WS_X8 = WS_TB + 128 * MiB;
constexpr size_t WS_LNX = WS_TB + 208 * MiB;
constexpr size_t WS_WTMP = WS_TB + 200 * MiB;
constexpr size_t WS_OPAIR = WS_R + 104 * MiB;
constexpr size_t WS_PPOS = WS_MISC + 4 * MiB;
constexpr size_t WS_LIST = WS_MISC, WS_GATE = WS_MISC + 2 * MiB;
static_assert((size_t)MOE_ROWS * EPAD <= 104 * MiB && 104 * MiB + (size_t)MOE_ROWS * DM * 2 <= 384 * MiB && (size_t)MOE_ROWS * EDIM * 2 <= 384 * MiB && (size_t)M * FFN * 2 <= 384 * MiB, "R region");
constexpr int CW_CNT = 64;
constexpr int CW_PAN = 8192;
constexpr int CW_XCC = 1024;
constexpr int CW_SIG = 33792;
constexpr int CW_BAR = 4096;

constexpr int RING_BYTES = 131072;
constexpr int MISC_OFF = RING_BYTES + 320;
constexpr int LNX_OFF = RING_BYTES + 4096;
constexpr int TAB_OFF = RING_BYTES + 1024;
constexpr int LDS_BYTES = 147456;

#define RLX_AGENT __ATOMIC_RELAXED, __HIP_MEMORY_SCOPE_AGENT
#define LDS_WAIT() asm volatile("s_waitcnt lgkmcnt(0)" ::: "memory")

__device__ __forceinline__ unsigned cvt_pk_bf16(float lo, float hi) { unsigned r; asm volatile("v_cvt_pk_bf16_f32 %0, %1, %2" : "=v"(r) : "v"(lo), "v"(hi)); return r; }
#ifndef WT_STORES
#define WT_STORES 0
#endif
__device__ __forceinline__ void st16(void* p, u32x4 v) {
#if WT_STORES
    asm volatile("global_store_dwordx4 %0, %1, off sc1\n\ts_nop 1" :: "v"(p), "v"(v) : "memory");
#else
    *(u32x4*)p = v;
#endif
}
__device__ __forceinline__ void st16f(void* p, f32x4 v) {
#if WT_STORES
    asm volatile("global_store_dwordx4 %0, %1, off sc1\n\ts_nop 1" :: "v"(p), "v"(v) : "memory");
#else
    *(f32x4*)p = v;
#endif
}
__device__ __forceinline__ void st8(void* p, u32x2 v) {
#if WT_STORES
    asm volatile("global_store_dwordx2 %0, %1, off sc1\n\ts_nop 1" :: "v"(p), "v"(v) : "memory");
#else
    *(u32x2*)p = v;
#endif
}
__device__ __forceinline__ float bf_lo(unsigned w) { return __uint_as_float(w << 16); }
__device__ __forceinline__ float bf_hi(unsigned w) { return __uint_as_float(w & 0xffff0000u); }
__device__ __forceinline__ float clamp448(float x) { return __builtin_amdgcn_fmed3f(x, -448.0f, 448.0f); }
__device__ __forceinline__ unsigned pk4_fp8(float a, float b, float c, float d) {
    int w = 0; w = __builtin_amdgcn_cvt_pk_fp8_f32(clamp448(a), clamp448(b), w, false); w = __builtin_amdgcn_cvt_pk_fp8_f32(clamp448(c), clamp448(d), w, true); return (unsigned)w; }
constexpr float S8_X = 16.0f, S8_W1 = 512.0f, S8_H = 16.0f, S8_W2 = 2048.0f;
__device__ __forceinline__ float wave_sum(float v) {
#pragma unroll
    for (int o = 1; o < 64; o <<= 1) v += __shfl_xor(v, o);
    return v;
}
__device__ __forceinline__ float fast_rcp(float x) { return __builtin_amdgcn_rcpf(x); }
__device__ __forceinline__ float silu_f(float g) { return g * fast_rcp(1.0f + __builtin_amdgcn_exp2f(-1.4426950408889634f * g)); }
__device__ __forceinline__ float gelu_tanh_f(float x) { const float y = x * (1.0f + 0.044715f * x * x); return x * fast_rcp(1.0f + __builtin_amdgcn_exp2f(-2.302208198f * y)); }

namespace pg8 {
constexpr int BM = 256, BK = 64, HALF = 128, HTB = HALF * BK * 2, STAGE_BYTES = 8 * HTB, NXCD = 8, WGM = 8;
__host__ __device__ __forceinline__ int lds_byte(int r, int c) { const int st = (r >> 4) * 2 + (c >> 5), rr = r & 15, cc = c & 31, ob = rr * 64 + cc * 2; return st * 1024 + (ob ^ (((ob >> 9) & 1) << 5)); }
__host__ __device__ __forceinline__ void stage_rc(int b, int& R, int& C) { const int st = b / 1024, sb = b % 1024, swz = sb ^ (((sb >> 9) & 1) << 5); R = (st >> 1) * 16 + swz / 64; C = (st & 1) * 32 + (swz % 64) / 2; }
__host__ __device__ __forceinline__ int perm32(int rho) { const int n = rho >> 4, i = rho & 15; return 8 * (i >> 2) + 4 * n + (i & 3); }

struct Unit { int pm, pn, ord; };
struct Gemm { const bf16* A; const bf16* Bt; int K; int lda; int zt = 0; };

struct StaticOrder {
    int nM, nN, nwg, G, c;
    __device__ void init(int Mr, int N, int G_, int c_) { nM = Mr / BM; nN = N / BM; nwg = nM * nN; G = G_; c = c_; }
    __device__ bool next(int i, Unit& u) const {
        const long L = (long)i * G + c; if (L >= nwg) return false;
        int wgid = (int)L; { const int q = nwg / NXCD, r = nwg % NXCD, xcd = wgid % NXCD, off = wgid / NXCD; wgid = (xcd < r ? xcd * (q + 1) : r * (q + 1) + (xcd - r) * q) + off; }
        const int nig = WGM * nN, gid = wgid / nig, fm = gid * WGM, gsz = (nM - fm) < WGM ? (nM - fm) : WGM;
        u.pm = fm + ((wgid % nig) % gsz); u.pn = (wgid % nig) / gsz; return true;
    }
    __device__ __forceinline__ int a_row(const Unit&, int, int) const { return 0; }
    __device__ __forceinline__ size_t a_coloff(const Unit&) const { return 0; }
};
struct PanelOrder {
    int c;
    __device__ bool next(int i, Unit& u) const { if (i >= 4) return false; const int x = c & 7, j = c >> 3; u.pm = 16 * x + 4 * i + (j >> 3); u.pn = j & 7; return true; }
    __device__ __forceinline__ int a_row(const Unit&, int, int) const { return 0; }
    __device__ __forceinline__ size_t a_coloff(const Unit&) const { return 0; }
};
struct FoldOrder {
    int c;
    __device__ bool next(int i, Unit& u) const { if (i > 0 || c >= 32) return false; u.pm = c & 7; u.pn = c >> 3; return true; }
    __device__ __forceinline__ int a_row(const Unit&, int, int) const { return 0; }
    __device__ __forceinline__ size_t a_coloff(const Unit& u) const { return (size_t)u.pn * 512; }
};
struct FlowSig { unsigned* sig; unsigned x, nloc, nx; };
__device__ __forceinline__ void flow_arrive(const FlowSig& f, int k) {
    unsigned* s = f.sig + k * 2048;
    const unsigned old = __hip_atomic_fetch_add(s + 64 * f.x, 1u, __ATOMIC_RELAXED, __HIP_MEMORY_SCOPE_AGENT);
    if (old + 1u == f.nloc) { __builtin_amdgcn_fence(__ATOMIC_RELEASE, "agent"); asm volatile("s_waitcnt vmcnt(0)" ::: "memory");
        (void)__hip_atomic_fetch_add(s + 1024, 1u, __ATOMIC_RELAXED, __HIP_MEMORY_SCOPE_AGENT); }
}
__device__ __forceinline__ void flow_wait(const FlowSig& f, int k) {
    unsigned* s = f.sig + k * 2048; unsigned sp = 0u;
    while (__hip_atomic_load(s + 1024, __ATOMIC_RELAXED, __HIP_MEMORY_SCOPE_AGENT) < f.nx) { __builtin_amdgcn_s_sleep(2); if (++sp > (1u << 19)) break; }
    __builtin_amdgcn_fence(__ATOMIC_ACQUIRE, "agent"); asm volatile("s_waitcnt vmcnt(0)" ::: "memory");
}
struct MoeOrder {
    int nM, nN, nwg, G, c, tile0, rep;
    const LAS int* tbase; const LAS int* tcnt; const LAS unsigned char* tileg; const int* list;
    FlowSig fl; int arrive_ui, rot, dep_nwg, dep_nN, dep_rsig;
    __device__ __forceinline__ int dep(const Unit& u) const {
        if (dep_nwg == 0) return 0;
        const int per = WGM * dep_nN, first = ((u.pm - tile0) / WGM) * per; int last = first + per - 1; if (last >= dep_nwg) last = dep_nwg - 1;
        const int q = dep_nwg / NXCD, r = dep_nwg % NXCD, cut = r * (q + 1);
        const int x0 = first < cut ? first / (q + 1) : r + (first - cut) / q;
        const int x1 = last < cut ? last / (q + 1) : r + (last - cut) / q, o1 = last < cut ? last % (q + 1) : (last - cut) % q;
        if (x0 != x1) return 2;
        return ((NXCD * o1 + x1) / G < dep_rsig) ? 1 : 2;
    }
    __device__ __forceinline__ bool next(int i, Unit& u) const {
        if (i >= ilim) return false;
        const long L0 = (long)(i + i0) * G + c; if (L0 >= (long)nwg * rep) return false; const long L = L0 % nwg;
        int wgid = (int)L; { const int q = nwg / NXCD, r = nwg % NXCD, xcd = wgid % NXCD; int off = wgid / NXCD; const int len = xcd < r ? q + 1 : q;
            if (rot) off = (off + rot) % len;
            wgid = (xcd < r ? xcd * (q + 1) : r * (q + 1) + (xcd - r) * q) + off; }
        const int nig = WGM * nN, gid = wgid / nig, fm = gid * WGM, gsz = (nM - fm) < WGM ? (nM - fm) : WGM;
        const int pm = tile0 + fm + ((wgid % nig) % gsz), pnl = (wgid % nig) / gsz;
        u.pm = pm; u.pn = (int)(tileg[pm] & 7) * nN + pnl; u.ord = i; return true;
    }
    const LAS int* rowtab; int i0, ilim;
    __device__ __forceinline__ int a_row_g(const Unit& u, int r) const {
        const int g = tileg[u.pm], pos = u.pm * 256 + r - tbase[g], c = tcnt[g];
        return list[g * LISTCAP + (pos < c ? pos : c - 1)];
    }
    __device__ __forceinline__ int a_row(const Unit&, int r, int ord) const { return rowtab[ord * 256 + r]; }
    __device__ __forceinline__ size_t a_coloff(const Unit&) const { return 0; }
};

struct EpiBf16 {
    static constexpr bool PERM = true; static constexpr bool IS_SWIGLU = false; static constexpr bool IS_PAIRS = false;
    bf16* O; int ldc;
    __device__ __forceinline__ void operator()(const f32x4 (&acc)[2][2][4][2], const Unit& u, int wr, int wc, int fr, int fq) const {
        const int row0 = u.pm * BM + wr * 64 + fr, col0 = u.pn * BM + wc * 32 + 8 * fq;
#pragma unroll
        for (int ai = 0; ai < 2; ++ai)
#pragma unroll
            for (int m = 0; m < 4; ++m) { bf16* rowp = O + (size_t)(row0 + ai * HALF + m * 16) * ldc + col0;
#pragma unroll
                for (int bj = 0; bj < 2; ++bj) { const f32x4 v0 = acc[ai][bj][m][0], v1 = acc[ai][bj][m][1];
                    u32x4 w; w.x = cvt_pk_bf16(v0[0], v0[1]); w.y = cvt_pk_bf16(v0[2], v0[3]); w.z = cvt_pk_bf16(v1[0], v1[1]); w.w = cvt_pk_bf16(v1[2], v1[3]);
                    st16(rowp + bj * HALF, w); } }
    }
};
struct EpiGeluStats {
    static constexpr bool PERM = true; static constexpr bool IS_SWIGLU = false; static constexpr bool IS_PAIRS = false;
    bf16* O; f32x2* vst;
    static __device__ __forceinline__ f32x2 gelu2(f32x2 x) {
        const f32x2 CK = {0.044715f * -2.302208198f, 0.044715f * -2.302208198f}, KK = {-2.302208198f, -2.302208198f}, ONE = {1.0f, 1.0f};
        const f32x2 a = x * __builtin_elementwise_fma(x * x, CK, KK);
        const f32x2 d = (f32x2){__builtin_amdgcn_exp2f(a[0]), __builtin_amdgcn_exp2f(a[1])} + ONE;
        return x * (f32x2){fast_rcp(d[0]), fast_rcp(d[1])};
    }
    template <bool ST>
    __device__ __forceinline__ void body(const f32x4 (&acc)[2][2][4][2], const Unit& u, int wr, int wc, int fr, int fq) const {
        const int row0 = u.pm * BM + wr * 64 + fr, col0 = u.pn * BM + wc * 32 + 8 * fq;
#pragma unroll
        for (int ai = 0; ai < 2; ++ai)
#pragma unroll
            for (int m = 0; m < 4; ++m) { const int row = row0 + ai * HALF + m * 16; bf16* rowp = O + (size_t)row * 4096 + col0; f32x2 s1 = {0.f, 0.f}, s2 = {0.f, 0.f};
#pragma unroll
                for (int bj = 0; bj < 2; ++bj) { const f32x4 v0 = acc[ai][bj][m][0], v1 = acc[ai][bj][m][1];
                    const f32x2 y0 = gelu2((f32x2){v0[0], v0[1]}), y1 = gelu2((f32x2){v0[2], v0[3]}), y2 = gelu2((f32x2){v1[0], v1[1]}), y3 = gelu2((f32x2){v1[2], v1[3]});
                    if (ST) { s1 += (y0 + y1) + (y2 + y3); s2 = __builtin_elementwise_fma(y0, y0, s2); s2 = __builtin_elementwise_fma(y1, y1, s2); s2 = __builtin_elementwise_fma(y2, y2, s2); s2 = __builtin_elementwise_fma(y3, y3, s2); }
                    u32x4 w; w.x = cvt_pk_bf16(y0[0], y0[1]); w.y = cvt_pk_bf16(y1[0], y1[1]); w.z = cvt_pk_bf16(y2[0], y2[1]); w.w = cvt_pk_bf16(y3[0], y3[1]);
                    st16(rowp + bj * HALF, w); }
                if (ST) { float t1 = s1[0] + s1[1], t2 = s2[0] + s2[1]; t1 += __shfl_xor(t1, 16); t1 += __shfl_xor(t1, 32); t2 += __shfl_xor(t2, 16); t2 += __shfl_xor(t2, 32);
                    if (fq == 0) vst[(size_t)row * 32 + (u.pn - 8) * 4 + wc] = (f32x2){t1, t2}; } }
    }
    __device__ __forceinline__ void operator()(const f32x4 (&acc)[2][2][4][2], const Unit& u, int wr, int wc, int fr, int fq) const {
        if (u.pn >= 8) body<true>(acc, u, wr, wc, fr, fq); else body<false>(acc, u, wr, wc, fr, fq);
    }
};
struct EpiRes {
    static constexpr bool PERM = true; static constexpr bool IS_SWIGLU = false; static constexpr bool IS_PAIRS = false;
    const bf16* res; bf16* T; float asc;
    __device__ __forceinline__ void operator()(const f32x4 (&acc)[2][2][4][2], const Unit& u, int wr, int wc, int fr, int fq) const {
        const int row0 = u.pm * BM + wr * 64 + fr, col0 = u.pn * BM + wc * 32 + 8 * fq;
        u32x4 rr[2][4][2];
#pragma unroll
        for (int ai = 0; ai < 2; ++ai)
#pragma unroll
            for (int m = 0; m < 4; ++m) { const bf16* rp_ = res + (size_t)(row0 + ai * HALF + m * 16) * DM + col0;
#pragma unroll
                for (int bj = 0; bj < 2; ++bj) rr[ai][m][bj] = *(const u32x4*)(rp_ + bj * HALF); }
#pragma unroll
        for (int ai = 0; ai < 2; ++ai)
#pragma unroll
            for (int m = 0; m < 4; ++m) { const size_t off = (size_t)(row0 + ai * HALF + m * 16) * DM + col0;
#pragma unroll
                for (int bj = 0; bj < 2; ++bj) { const u32x4 r = rr[ai][m][bj]; const f32x4 v0 = acc[ai][bj][m][0] * asc, v1 = acc[ai][bj][m][1] * asc;
                    u32x4 w; w.x = cvt_pk_bf16(bf_lo(r.x) * DN_ALPHA + v0[0], bf_hi(r.x) * DN_ALPHA + v0[1]); w.y = cvt_pk_bf16(bf_lo(r.y) * DN_ALPHA + v0[2], bf_hi(r.y) * DN_ALPHA + v0[3]);
                    w.z = cvt_pk_bf16(bf_lo(r.z) * DN_ALPHA + v1[0], bf_hi(r.z) * DN_ALPHA + v1[1]); w.w = cvt_pk_bf16(bf_lo(r.w) * DN_ALPHA + v1[2], bf_hi(r.w) * DN_ALPHA + v1[3]);
                    st16(T + off + bj * HALF, w); } }
    }
};
__device__ __forceinline__ float quad_sum(float v) {
    const auto a = __builtin_amdgcn_permlane16_swap(__float_as_uint(v), __float_as_uint(v), false, false);
    const float t = __uint_as_float(a[0]) + __uint_as_float(a[1]);
    const auto b = __builtin_amdgcn_permlane32_swap(__float_as_uint(t), __float_as_uint(t), false, false);
    return __uint_as_float(b[0]) + __uint_as_float(b[1]);
}
struct EpiResLn {
    static constexpr bool PERM = true; static constexpr bool IS_SWIGLU = false; static constexpr bool IS_PAIRS = false;
    const bf16* res; bf16* XBo; float asc; const float* gam; const float* bet; unsigned long long* slots; int fast; LAS unsigned char* sp; unsigned char* X8o;
    __device__ __forceinline__ void stage_affine(int pn) const { const int tid = threadIdx.x; LAS float* gl = (LAS float*)(sp + 10240);
        if (tid < 256) gl[tid] = gam[pn * BM + tid]; else gl[tid] = bet[pn * BM + tid - 256];
        __syncthreads(); }
    __device__ __forceinline__ void operator()(f32x4 (&acc)[2][2][4][2], const Unit& u, int wr, int wc, int fr, int fq) const {
        const int tid = threadIdx.x, lane = tid & 63, wid = tid >> 6;
        const int row0 = u.pm * BM + wr * 64 + fr, col0 = u.pn * BM + wc * 32 + 8 * fq;
        LAS f32x2* Pt = (LAS f32x2*)sp; LAS f32x2* St = (LAS f32x2*)(sp + 8192);
        unsigned long long p3_t = 0ull; if (MK_PROBE_EPI == 3 || MK_PROBE_EPI == 4 || MK_PROBE_EPI == 6) p3_t = __builtin_amdgcn_s_memrealtime();
        const f32x2 AL2 = {DN_ALPHA, DN_ALPHA}, AS2 = {asc, asc};
        u32x4 rrA[4][2], rrB[4][2];
        LAS f32x2* ptb = Pt + (wr * 64 + fr) * 4 + wc; asm volatile("" : "+v"(ptb));
#define LNE_LOAD(dst, ai_, m_) do { const bf16* rp_ = res + (size_t)(row0 + (ai_) * HALF + (m_) * 16) * DM + col0; dst[m_][0] = *(const u32x4*)rp_; dst[m_][1] = *(const u32x4*)(rp_ + HALF); } while (0)
#define LNE_ROWS(src, ai_, m_) do { f32x2 p1 = {0.f, 0.f}, p2 = {0.f, 0.f}; \
            _Pragma("unroll") for (int bj = 0; bj < 2; ++bj) { const u32x4 r = src[m_][bj]; \
                _Pragma("unroll") for (int q = 0; q < 4; ++q) { const unsigned w = r[q]; const f32x2 x2 = {bf_lo(w), bf_hi(w)}, a2 = {acc[ai_][bj][m_][q >> 1][2 * (q & 1)], acc[ai_][bj][m_][q >> 1][2 * (q & 1) + 1]}; \
                    const f32x2 t2 = __builtin_elementwise_fma(x2, AL2, a2 * AS2); \
                    acc[ai_][bj][m_][q >> 1][2 * (q & 1)] = t2[0]; acc[ai_][bj][m_][q >> 1][2 * (q & 1) + 1] = t2[1]; \
                    p1 += t2; p2 = __builtin_elementwise_fma(t2, t2, p2); } } \
            float s1 = p1[0] + p1[1], s2 = p2[0] + p2[1]; \
            s1 = quad_sum(s1); s2 = quad_sum(s2);                                             \
            if (fq == 0) ptb[((ai_) * HALF + (m_) * 16) * 4] = (f32x2){s1, s2}; } while (0)
        LNE_LOAD(rrA, 0, 0); LNE_LOAD(rrA, 0, 1); LNE_LOAD(rrA, 0, 2); LNE_LOAD(rrA, 0, 3); LNE_LOAD(rrB, 1, 0); LNE_LOAD(rrB, 1, 1);
        if (MK_PROBE_EPI == 6) { asm volatile("s_waitcnt vmcnt(0)" ::: "memory"); if (tid == 0) { volatile LAS unsigned long long* pa = (volatile LAS unsigned long long*)(sp - 4096 + 320 + 80); *pa = *pa + (__builtin_amdgcn_s_memrealtime() - p3_t); } }
        LNE_ROWS(rrA, 0, 0); asm volatile("" ::: "memory"); LNE_LOAD(rrB, 1, 2);
        LNE_ROWS(rrA, 0, 1); asm volatile("" ::: "memory"); LNE_LOAD(rrB, 1, 3);
        LNE_ROWS(rrA, 0, 2); LNE_ROWS(rrA, 0, 3);
        LNE_ROWS(rrB, 1, 0); LNE_ROWS(rrB, 1, 1); LNE_ROWS(rrB, 1, 2); LNE_ROWS(rrB, 1, 3);
#undef LNE_LOAD
#undef LNE_ROWS
        if (MK_PROBE_EPI == 4 && tid == 0) { volatile LAS unsigned long long* pa = (volatile LAS unsigned long long*)(sp - 4096 + 320 + 80); *pa = *pa + (__builtin_amdgcn_s_memrealtime() - p3_t); }
        asm volatile("s_waitcnt lgkmcnt(0)" ::: "memory"); __builtin_amdgcn_s_barrier(); asm volatile("" ::: "memory");
        if (tid < 256) { const f32x2 a = Pt[tid * 4 + 0], b = Pt[tid * 4 + 1], c = Pt[tid * 4 + 2], d = Pt[tid * 4 + 3];
            const float S1 = (a[0] + b[0]) + (c[0] + d[0]), S2 = (a[1] + b[1]) + (c[1] + d[1]);
            unsigned long long* sl = slots + (size_t)(u.pm * BM + tid) * 8;
            const unsigned long long pub = ((unsigned long long)(__float_as_uint(S2) | 1u) << 32) | __float_as_uint(S1);
            if (fast) __hip_atomic_store(sl + u.pn, pub, __ATOMIC_RELAXED, __HIP_MEMORY_SCOPE_WORKGROUP); else __hip_atomic_store(sl + u.pn, pub, __ATOMIC_RELAXED, __HIP_MEMORY_SCOPE_AGENT);
            unsigned long long wv[8]; unsigned sp_ = 0; unsigned long long pp_t = 0ull; if (MK_PROBE_EPI == 2) pp_t = __builtin_amdgcn_s_memrealtime();
            for (;;) { unsigned ok = 1u;
#pragma unroll
                for (int t = 0; t < 8; ++t) { wv[t] = __hip_atomic_load(sl + t, __ATOMIC_RELAXED, __HIP_MEMORY_SCOPE_AGENT); }
#pragma unroll
                for (int t = 0; t < 8; ++t) ok &= ((unsigned)(wv[t] >> 32) != 0u) ? 1u : 0u;
                if (ok) break;
                __builtin_amdgcn_s_sleep(1); if (++sp_ > (1u << 18)) break; }
            if (MK_PROBE_EPI == 2 && tid == 0) { volatile LAS unsigned long long* pa = (volatile LAS unsigned long long*)(sp - 4096 + 320 + 80); *pa = *pa + (__builtin_amdgcn_s_memrealtime() - pp_t); }
            float T1 = 0.f, T2 = 0.f;
#pragma unroll
            for (int t = 0; t < 8; ++t) { T1 += __uint_as_float((unsigned)wv[t]); T2 += __uint_as_float((unsigned)(wv[t] >> 32)); }
            const float mean = T1 * (1.0f / DM), var = fmaxf(T2 * (1.0f / DM) - mean * mean, 0.f);
            St[tid] = (f32x2){mean, 1.0f / sqrtf(var + LN_EPS)}; }
        asm volatile("s_waitcnt vmcnt(0) lgkmcnt(0)" ::: "memory"); __builtin_amdgcn_s_barrier(); asm volatile("" ::: "memory");
        const LAS f32x2* stb = St + wr * 64 + fr; asm volatile("" : "+v"(stb));
        unsigned long long p5_t = 0ull; if (MK_PROBE_EPI == 5) p5_t = __builtin_amdgcn_s_memrealtime();
#pragma unroll
        for (int bj = 0; bj < 2; ++bj) { const LAS float* gl = (const LAS float*)(sp + 10240) + wc * 32 + 8 * fq + bj * HALF;
            const f32x4 g0 = *(const LAS f32x4*)gl, g1 = *(const LAS f32x4*)(gl + 4), b0 = *(const LAS f32x4*)(gl + 256), b1 = *(const LAS f32x4*)(gl + 260);
            const f32x2 G2[4] = {{g0[0], g0[1]}, {g0[2], g0[3]}, {g1[0], g1[1]}, {g1[2], g1[3]}}, B2[4] = {{b0[0], b0[1]}, {b0[2], b0[3]}, {b1[0], b1[1]}, {b1[2], b1[3]}};
            const f32x2 SX2 = {S8_X, S8_X};
            const f32x2 G8[4] = {G2[0] * SX2, G2[1] * SX2, G2[2] * SX2, G2[3] * SX2}, B8[4] = {B2[0] * SX2, B2[1] * SX2, B2[2] * SX2, B2[3] * SX2};
#pragma unroll
            for (int ai = 0; ai < 2; ++ai)
#pragma unroll
                for (int m = 0; m < 4; ++m) { const f32x2 ms = stb[ai * HALF + m * 16];
                    const f32x2 R2 = {ms[1], ms[1]}, M2 = {-ms[0] * ms[1], -ms[0] * ms[1]};
                    f32x2 t[4], y[4];
#pragma unroll
                    for (int q = 0; q < 4; ++q) { const f32x2 a2 = {acc[ai][bj][m][q >> 1][2 * (q & 1)], acc[ai][bj][m][q >> 1][2 * (q & 1) + 1]};
                        t[q] = __builtin_elementwise_fma(a2, R2, M2); y[q] = __builtin_elementwise_fma(t[q], G2[q], B2[q]); }
                    u32x4 w; w.x = cvt_pk_bf16(y[0][0], y[0][1]); w.y = cvt_pk_bf16(y[1][0], y[1][1]); w.z = cvt_pk_bf16(y[2][0], y[2][1]); w.w = cvt_pk_bf16(y[3][0], y[3][1]);
                    st16(XBo + (size_t)(row0 + ai * HALF + m * 16) * DM + col0 + bj * HALF, w);
                    if (X8o) { f32x2 z[4];
#pragma unroll
                        for (int q = 0; q < 4; ++q) z[q] = __builtin_elementwise_fma(t[q], G8[q], B8[q]);
                        u32x2 w8; w8.x = pk4_fp8(z[0][0], z[0][1], z[1][0], z[1][1]); w8.y = pk4_fp8(z[2][0], z[2][1], z[3][0], z[3][1]);
                        st8(X8o + (size_t)(row0 + ai * HALF + m * 16) * DM + col0 + bj * HALF, w8); } } }
        if (MK_PROBE_EPI == 5 && tid == 0) { volatile LAS unsigned long long* pa = (volatile LAS unsigned long long*)(sp - 4096 + 320 + 80); *pa = *pa + (__builtin_amdgcn_s_memrealtime() - p5_t); }
        if (MK_PROBE_EPI == 3 && tid == 0) { volatile LAS unsigned long long* pa = (volatile LAS unsigned long long*)(sp - 4096 + 320 + 80); *pa = *pa + (__builtin_amdgcn_s_memrealtime() - p3_t); }
    }
};
struct EpiSwiglu8 {
    static constexpr bool PERM = true; static constexpr bool IS_SWIGLU = true; static constexpr bool IS_PAIRS = false;
    unsigned char* H; int ldh, NT; float asc; int zpad;
    __device__ __forceinline__ void operator()(const f32x4 (&acc)[2][2][4][2], const Unit& u, int wr, int wc, int fr, int fq) const {
        const int row0 = u.pm * BM + wr * 64 + fr, col0 = (u.pn % NT) * HALF + wc * 32 + 8 * fq;
        const float cc = asc * asc * S8_H, kk = -1.4426950408889634f * asc, bb = -__builtin_amdgcn_logf(cc), ic = fast_rcp(cc);
        const f32x2 K2 = {kk, kk}, B2 = {bb, bb}, IC2 = {ic, ic};
#pragma unroll
        for (int ai = 0; ai < 2; ++ai)
#pragma unroll
            for (int m = 0; m < 4; ++m) { unsigned char* rowp = H + (size_t)(row0 + ai * HALF + m * 16) * ldh + col0; float o[8];
#pragma unroll
                for (int n = 0; n < 2; ++n)
#pragma unroll
                    for (int h = 0; h < 2; ++h) {
                        const f32x2 g2 = {acc[ai][0][m][n][2 * h], acc[ai][0][m][n][2 * h + 1]}, u2 = {acc[ai][1][m][n][2 * h], acc[ai][1][m][n][2 * h + 1]};
                        const f32x2 a2 = __builtin_elementwise_fma(g2, K2, B2);
                        const f32x2 d2 = (f32x2){__builtin_amdgcn_exp2f(a2[0]), __builtin_amdgcn_exp2f(a2[1])} + IC2;
                        const f32x2 o2 = (g2 * u2) * (f32x2){fast_rcp(d2[0]), fast_rcp(d2[1])};
                        o[4 * n + 2 * h] = o2[0]; o[4 * n + 2 * h + 1] = o2[1]; }
                u32x2 w; w.x = pk4_fp8(o[0], o[1], o[2], o[3]); w.y = pk4_fp8(o[4], o[5], o[6], o[7]);
                st8(rowp, w);
                if (zpad && (u.pn % NT) == NT - 1) { const u32x2 z = {0u, 0u}; st8(rowp + HALF, z); } }
    }
};
struct EpiMoePairs {
    static constexpr bool PERM = true; static constexpr bool IS_SWIGLU = false; static constexpr bool IS_PAIRS = true;
    bf16* O; const LAS float* gtab; float asc;
    const LAS int* tbase; const LAS int* tcnt; const LAS unsigned char* tileg;
    __device__ __forceinline__ void operator()(const f32x4 (&acc)[2][2][4][2], const Unit& u, int wr, int wc, int fr, int fq) const {
        const int g = tileg[u.pm], pos0 = u.pm * BM - tbase[g], cnt = tcnt[g];
        const int col0 = (u.pn & 7) * BM + wc * 32 + 8 * fq;
        float gt[2][4];
#pragma unroll
        for (int ai = 0; ai < 2; ++ai)
#pragma unroll
            for (int m = 0; m < 4; ++m) gt[ai][m] = gtab[u.ord * 256 + ai * HALF + wr * 64 + m * 16 + fr];
#pragma unroll
        for (int ai = 0; ai < 2; ++ai)
#pragma unroll
            for (int m = 0; m < 4; ++m) { const int rl = ai * HALF + wr * 64 + m * 16 + fr, pos = pos0 + rl;
                if (pos < cnt) { const float gs = gt[ai][m] * asc; bf16* rowp = O + (size_t)(u.pm * BM + rl) * DM + col0;
#pragma unroll
                    for (int bj = 0; bj < 2; ++bj) { const f32x4 v0 = acc[ai][bj][m][0] * gs, v1 = acc[ai][bj][m][1] * gs;
                        u32x4 w; w.x = cvt_pk_bf16(v0[0], v0[1]); w.y = cvt_pk_bf16(v0[2], v0[3]); w.z = cvt_pk_bf16(v1[0], v1[1]); w.w = cvt_pk_bf16(v1[2], v1[3]);
                        st16(rowp + bj * HALF, w); } } }
    }
};

template <class Epi, class Sched, bool GATHER, bool F8 = false, bool FLOW = false>
__device__ __forceinline__ void gemm_phase(LAS unsigned char* lds, const Gemm g, const Sched& S, const Epi& E) {
    const int tid = threadIdx.x, wid = __builtin_amdgcn_readfirstlane(tid >> 6), lane = tid & 63, wr = wid >> 2, wc = wid & 3, fr = lane & 15, fq = lane >> 4;
    constexpr int ES = F8 ? 1 : 2;
    const int K = g.K, nt = K * ES / (BK * 2), lda = g.lda;
    unsigned voffB[2]; int RA[2], CA[2];
#pragma unroll
    for (int i = 0; i < 2; ++i) { int R, C; stage_rc(tid * 16 + i * 8192, R, C); const int Rb = Epi::PERM ? ((R & ~31) + perm32(R & 31)) : R;
        RA[i] = R; CA[i] = C; voffB[i] = (unsigned)(Rb * K) * ES + (unsigned)C * 2u; }
    const size_t kstep = (size_t)(BK * 2);
    const size_t hstep = (size_t)HALF * K * ES;
    const size_t tstep = 2 * hstep;
    const size_t hstepA = (size_t)HALF * lda * ES, tstepA = 2 * hstepA;
    const unsigned ldsw = (unsigned)wid * 1024u;
    const int aoff = lds_byte(wr * 64 + fr, fq * 8), boff = lds_byte(wc * 32 + fr, fq * 8);
#define PG8_SA(b, h) (((b) * 2 + (h)) * HTB)
#define PG8_SB(b, h) ((4 + (b) * 2 + (h)) * HTB)
#define PG8_STAGE(bufoff, gbase, voff) do { _Pragma("unroll") for (int _i = 0; _i < 2; ++_i) \
        __builtin_amdgcn_global_load_lds((const unsigned*)((const char*)(gbase) + (voff)[_i]), (LAS unsigned*)(lds + (bufoff) + ldsw + _i * 8192), 16, 0, 0); } while (0)
#define PG8_LD8(p) __builtin_bit_cast(i32x8, __builtin_shufflevector(*(const LAS u32x4*)(p), *(const LAS u32x4*)((p) + 1024), 0, 1, 2, 3, 4, 5, 6, 7))
#define PG8_LDA(dst, b, h) do { if (F8) { _Pragma("unroll") for (int m = 0; m < 4; ++m) dst##8[m] = PG8_LD8(lds + PG8_SA(b, h) + aoff + m * 2048); } \
        else { _Pragma("unroll") for (int m = 0; m < 4; ++m) _Pragma("unroll") for (int k = 0; k < 2; ++k) dst[m][k] = *(const LAS bf16x8*)(lds + PG8_SA(b, h) + aoff + m * 2048 + k * 1024); } } while (0)
#define PG8_LDB(dst, b, h) do { if (F8) { _Pragma("unroll") for (int n = 0; n < 2; ++n) dst##8[n] = PG8_LD8(lds + PG8_SB(b, h) + boff + n * 2048); } \
        else { _Pragma("unroll") for (int n = 0; n < 2; ++n) _Pragma("unroll") for (int k = 0; k < 2; ++k) dst[n][k] = *(const LAS bf16x8*)(lds + PG8_SB(b, h) + boff + n * 2048 + k * 1024); } } while (0)
#define PG8_CAT(X) __builtin_shufflevector(__builtin_bit_cast(u32x4, (X)[0]), __builtin_bit_cast(u32x4, (X)[1]), 0, 1, 2, 3, 4, 5, 6, 7)
#define PG8_MMA(ai, bj, At, Bt) do { __builtin_amdgcn_s_setprio(1); \
        if (F8) { _Pragma("unroll") for (int m = 0; m < 4; ++m) _Pragma("unroll") for (int n = 0; n < 2; ++n) \
            asm volatile("v_mfma_scale_f32_16x16x128_f8f6f4 %0, %1, %2, %0, %3, %3 op_sel_hi:[0,0,0]" : "+v"(acc[ai][bj][m][n]) : "v"(Bt##8[n]), "v"(At##8[m]), "v"(one_scale)); } \
        else { _Pragma("unroll") for (int m = 0; m < 4; ++m) _Pragma("unroll") for (int n = 0; n < 2; ++n) _Pragma("unroll") for (int k = 0; k < 2; ++k) \
            acc[ai][bj][m][n] = __builtin_amdgcn_mfma_f32_16x16x32_bf16(Bt[n][k], At[m][k], acc[ai][bj][m][n], 0, 0, 0); } \
        __builtin_amdgcn_s_setprio(0); } while (0)
#define PG8_WAIT_V(n) asm volatile("s_waitcnt vmcnt(" #n ")" ::: "memory")
#define PG8_WAIT_L(n) asm volatile("s_waitcnt lgkmcnt(" #n ")" ::: "memory")
#define PG8_BAR __builtin_amdgcn_s_barrier()
#define PG8_SCHED __builtin_amdgcn_sched_barrier(0)
    Unit cur, nxt; int ui = 0; int seen = 0;
    if (!S.next(0, cur)) return;
    if constexpr (FLOW) { const int need = S.dep(cur); if (need > seen) { if (tid == 0) flow_wait(S.fl, need - 1); __syncthreads(); seen = need; } }
    f32x4 acc[2][2][4][2];
#pragma unroll
    for (int a = 0; a < 2; ++a)
#pragma unroll
        for (int b = 0; b < 2; ++b)
#pragma unroll
            for (int m = 0; m < 4; ++m)
#pragma unroll
                for (int n = 0; n < 2; ++n) acc[a][b][m][n] = (f32x4){0.f, 0.f, 0.f, 0.f};
    bf16x8 At[4][2], B0[2][2], B1[2][2]; i32x8 At8[4], B08[2], B18[2]; const int one_scale = 0x7f7f7f7f;
    unsigned cv0[2], cv1[2], nv0[2], nv1[2];
#define PG8_ROWS(U, V0, V1, ORD) do { _Pragma("unroll") for (int _i = 0; _i < 2; ++_i) { \
        if (GATHER) { V0[_i] = (unsigned)(S.a_row(U, RA[_i], ORD) * lda) * ES + (unsigned)CA[_i] * 2u; V1[_i] = (unsigned)(S.a_row(U, HALF + RA[_i], ORD) * lda) * ES + (unsigned)CA[_i] * 2u; } \
        else { V0[_i] = (unsigned)(RA[_i] * lda) * ES + (unsigned)CA[_i] * 2u; V1[_i] = 0u; } } } while (0)
#define PG8_STAGE_A(bufoff, gbase, hf, V0, V1) do { if (GATHER) { if (hf) PG8_STAGE(bufoff, gbase, V1); else PG8_STAGE(bufoff, gbase, V0); } \
        else PG8_STAGE(bufoff, (gbase) + ((hf) ? hstepA : 0), V0); } while (0)
    PG8_ROWS(cur, cv0, cv1, 0);
    const char* cA = GATHER ? (const char*)g.A : (const char*)g.A + (size_t)cur.pm * tstepA + S.a_coloff(cur); const char* cB = (const char*)g.Bt + (size_t)cur.pn * tstep;
    PG8_STAGE(PG8_SB(0, 0), cB, voffB); PG8_STAGE(PG8_SB(0, 1), cB + hstep, voffB); PG8_STAGE_A(PG8_SA(0, 0), cA, 0, cv0, cv1); PG8_STAGE_A(PG8_SA(0, 1), cA, 1, cv0, cv1);
    if (wr == 1) PG8_BAR;
    PG8_WAIT_V(2); PG8_BAR;
    PG8_STAGE(PG8_SB(1, 0), cB + kstep, voffB); PG8_STAGE_A(PG8_SA(1, 0), cA + kstep, 0, cv0, cv1); PG8_STAGE(PG8_SB(1, 1), cB + hstep + kstep, voffB);
    PG8_WAIT_V(6); PG8_BAR;
    for (;;) {
        const bool has_next = S.next(ui + 1, nxt);
        if constexpr (FLOW) { if (has_next) { const int need = S.dep(nxt);
            if (need > seen) { if (tid == 0) flow_wait(S.fl, need - 1); PG8_BAR; seen = need; } } }
        const char* nA = GATHER ? (const char*)g.A : (has_next ? (const char*)g.A + (size_t)nxt.pm * tstepA + S.a_coloff(nxt) : cA); const char* nB = has_next ? (const char*)g.Bt + (size_t)nxt.pn * tstep : cB;
        if (GATHER && has_next) PG8_ROWS(nxt, nv0, nv1, ui + 1); else {
#pragma unroll
            for (int _i = 0; _i < 2; ++_i) { nv0[_i] = cv0[_i]; nv1[_i] = cv1[_i]; } }
        unsigned long long pk_t = 0ull; if ((MK_PROBE_EPI == 7 && GATHER) || (MK_PROBE_EPI == 8 && !GATHER && F8 && Epi::IS_SWIGLU) || (MK_PROBE_EPI == 9 && Epi::IS_PAIRS)) pk_t = __builtin_amdgcn_s_memrealtime();
        for (int t = 0; t < nt; t += 2) {
            const bool last = (t == nt - 2);
            const bool zt = last && g.zt;
            const char* a1 = cA + (size_t)(t + 1) * kstep;
            const char* a2 = last ? nA : cA + (size_t)(t + 2) * kstep; const char* b2 = last ? nB : cB + (size_t)(t + 2) * kstep;
            const char* a3 = a2 + kstep; const char* b3 = b2 + kstep;
            unsigned w0[2], w1[2];
#pragma unroll
            for (int _i = 0; _i < 2; ++_i) { w0[_i] = last ? nv0[_i] : cv0[_i]; w1[_i] = last ? nv1[_i] : cv1[_i]; }
            PG8_LDB(B0, 0, 0); PG8_LDB(B1, 0, 1); PG8_SCHED; PG8_LDA(At, 0, 0); PG8_STAGE_A(PG8_SA(1, 1), a1, 1, cv0, cv1);
            PG8_WAIT_V(8); PG8_WAIT_L(0); PG8_BAR; PG8_MMA(0, 0, At, B0); PG8_MMA(0, 1, At, B1); PG8_BAR; PG8_SCHED;
            PG8_LDA(At, 0, 1); PG8_STAGE(PG8_SB(0, 0), b2, voffB); PG8_STAGE(PG8_SB(0, 1), b2 + hstep, voffB); PG8_STAGE_A(PG8_SA(0, 0), a2, 0, w0, w1);
            PG8_WAIT_V(8); PG8_WAIT_L(0); PG8_BAR; PG8_MMA(1, 0, At, B0); PG8_MMA(1, 1, At, B1); PG8_BAR; PG8_SCHED;
            if (!zt) { PG8_LDB(B0, 1, 0); PG8_LDB(B1, 1, 1); PG8_SCHED; PG8_LDA(At, 1, 0); } PG8_STAGE_A(PG8_SA(0, 1), a2, 1, w0, w1);
            PG8_WAIT_V(8); PG8_WAIT_L(0); PG8_BAR; if (!zt) { PG8_MMA(0, 0, At, B0); PG8_MMA(0, 1, At, B1); } PG8_BAR; PG8_SCHED;
            if (!zt) PG8_LDA(At, 1, 1); PG8_STAGE(PG8_SB(1, 0), b3, voffB); PG8_STAGE(PG8_SB(1, 1), b3 + hstep, voffB); PG8_STAGE_A(PG8_SA(1, 0), a3, 0, w0, w1);
            PG8_WAIT_V(8); PG8_WAIT_L(0); PG8_BAR; if (!zt) { PG8_MMA(1, 0, At, B0); PG8_MMA(1, 1, At, B1); } PG8_BAR; PG8_SCHED;
        }
        if (((MK_PROBE_EPI == 7 && GATHER) || (MK_PROBE_EPI == 8 && !GATHER && F8 && Epi::IS_SWIGLU) || (MK_PROBE_EPI == 9 && Epi::IS_PAIRS)) && tid == 0) { volatile LAS unsigned long long* pa = (volatile LAS unsigned long long*)(lds + RING_BYTES + 320 + 80); *pa = *pa + (__builtin_amdgcn_s_memrealtime() - pk_t); }
        if (wr == 0) PG8_BAR;
        if (F8) asm volatile("s_nop 15\n\ts_nop 15" ::: "memory");
        unsigned long long pe_t = 0ull; if (MK_PROBE_EPI == 1) pe_t = __builtin_amdgcn_s_memrealtime();
        E(acc, cur, wr, wc, fr, fq);
        if (MK_PROBE_EPI == 1 && tid == 0) { volatile LAS unsigned long long* pa = (volatile LAS unsigned long long*)(lds + RING_BYTES + 320 + 80); *pa = *pa + (__builtin_amdgcn_s_memrealtime() - pe_t); }
        if constexpr (FLOW) { if (has_next && ui == S.arrive_ui) { PG8_WAIT_V(0); PG8_BAR; if (tid == 0) flow_arrive(S.fl, 0); } }
        if (!has_next) break;
#pragma unroll
        for (int a = 0; a < 2; ++a)
#pragma unroll
            for (int b = 0; b < 2; ++b)
#pragma unroll
                for (int m = 0; m < 4; ++m)
#pragma unroll
                    for (int n = 0; n < 2; ++n) acc[a][b][m][n] = (f32x4){0.f, 0.f, 0.f, 0.f};
        cur = nxt; cA = nA; cB = nB; ++ui;
#pragma unroll
        for (int _i = 0; _i < 2; ++_i) { cv0[_i] = nv0[_i]; cv1[_i] = nv1[_i]; }
        if (wr == 1) PG8_BAR;
    }
    PG8_WAIT_V(0);
    PG8_BAR;
#undef PG8_ROWS
#undef PG8_STAGE_A
#undef PG8_SA
#undef PG8_SB
#undef PG8_STAGE
#undef PG8_LDA
#undef PG8_LDB
#undef PG8_MMA
#undef PG8_CAT
#undef PG8_LD8
#undef PG8_WAIT_V
#undef PG8_WAIT_L
#undef PG8_BAR
#undef PG8_SCHED
}
}

#define XB_TMO      128
#define XB_XCNT(j)  (256  + 64 * (j))
#define XB_XSUB(j)  (1280 + 64 * (j))
#define XB_XGEN(j)  (2304 + 64 * (j))
#define XB_TOP      3328
#define XB_TOPGEN   3392
#define XCD_BAR_WORDS 3456
#define XB_SPIN_CAP (1u << 18)
__device__ __forceinline__ unsigned xb_ld(unsigned* p)              { return __hip_atomic_load(p, __ATOMIC_RELAXED, __HIP_MEMORY_SCOPE_AGENT); }
__device__ __forceinline__ unsigned xb_add(unsigned* p, unsigned v) { return __hip_atomic_fetch_add(p, v, __ATOMIC_RELAXED, __HIP_MEMORY_SCOPE_AGENT); }
__device__ __forceinline__ unsigned xb_xcc_id() { return (unsigned)__builtin_amdgcn_s_getreg((3 << 11) | 20) & 0xFu; }
#define XB_SPIN(cond, bar) do { unsigned _sp = 0; while (cond) { __builtin_amdgcn_s_sleep(1); \
    if ((++_sp & 255u) == 0u) { if (xb_ld(&(bar)[XB_TMO])) break; if (_sp > XB_SPIN_CAP) { atomicAdd(&(bar)[XB_TMO], 1u); break; } } } } while (0)
struct XcdBarrier { unsigned* bar; unsigned x; volatile LAS unsigned* st; };
__device__ __forceinline__ XcdBarrier xcd_barrier_post(unsigned* bar, volatile LAS unsigned* st) {
    XcdBarrier b; b.bar = bar; b.x = xb_xcc_id(); b.st = st;
    if (threadIdx.x == 0) (void)xb_add(&bar[XB_XCNT(b.x)], 1u);
    return b;
}
__device__ __forceinline__ void xcd_barrier_complete(unsigned* bar, unsigned x, unsigned& nloc, unsigned& nx) {
    const unsigned G = gridDim.x * gridDim.y * gridDim.z;
    unsigned sum, cnt, mine, sp = 0u;
    for (;;) {
        sum = 0u; cnt = 0u; mine = 0u;
#pragma unroll
        for (unsigned j = 0; j < 16; ++j) { const unsigned c = xb_ld(&bar[XB_XCNT(j)]); sum += c; cnt += (c > 0u) ? 1u : 0u; mine = (j == x) ? c : mine; }
        if (sum == G) break;
        __builtin_amdgcn_s_sleep(1);
        if ((++sp & 255u) == 0u) { if (xb_ld(&bar[XB_TMO])) break; if (sp > XB_SPIN_CAP) { atomicAdd(&bar[XB_TMO], 1u); break; } }
    }
    nloc = mine > 0u ? mine : 1u; nx = cnt > 0u ? cnt : 1u;
}
__device__ __forceinline__ void xcd_barrier(const XcdBarrier& b) {
    asm volatile("s_waitcnt vmcnt(0)" ::: "memory");
    __syncthreads();
    if (threadIdx.x == 0) {
        unsigned* bar = b.bar;
        __builtin_amdgcn_s_waitcnt(0);
        unsigned nloc = b.st[0], nx = b.st[1];
        if (nloc == 0u) { xcd_barrier_complete(bar, b.x, nloc, nx); b.st[0] = nloc; b.st[1] = nx; }
        const unsigned old = xb_add(&bar[XB_XSUB(b.x)], 1u);
        const unsigned gen = old / nloc;
        if (old + 1u == (gen + 1u) * nloc) {
            __builtin_amdgcn_fence(__ATOMIC_RELEASE, "agent");
            asm volatile("s_waitcnt vmcnt(0)" ::: "memory");
            const unsigned og = xb_add(&bar[XB_TOP], 1u);
            const unsigned tg = og / nx;
            if (og + 1u == (tg + 1u) * nx) xb_add(&bar[XB_TOPGEN], 1u);
            else XB_SPIN(xb_ld(&bar[XB_TOPGEN]) == tg, bar);
            __builtin_amdgcn_fence(__ATOMIC_ACQUIRE, "agent");
            xb_add(&bar[XB_XGEN(b.x)], 1u);
            asm volatile("s_waitcnt vmcnt(0)" ::: "memory");
        } else {
            XB_SPIN(xb_ld(&bar[XB_XGEN(b.x)]) == gen, bar);
            __builtin_amdgcn_fence(__ATOMIC_ACQUIRE, "agent");
            asm volatile("s_waitcnt vmcnt(0)" ::: "memory");
        }
    }
    __syncthreads();
}

struct Ctx { LAS unsigned char* lds; int tid, lane, wave, G, wg; };

struct TrDesc { const float* src; int N; unsigned char* dst; int K; int kind; float sc; };
__device__ __forceinline__ void tr_load(const TrDesc& d, f32x4 (&tv)[16], int lane) {
    if (d.kind < 2) {
#pragma unroll
        for (int i = 0; i < 16; ++i) tv[i] = *(const f32x4*)(d.src + (size_t)(8 * i + (lane >> 3)) * d.N + 4 * (lane & 7)); }
}
__device__ __forceinline__ void tr_process(const TrDesc& d, const f32x4 (&tv)[16], LAS float* scr, int lane) {
    if (d.kind >= 2) return;
#pragma unroll
    for (int i = 0; i < 16; ++i) { LAS float* q = scr + (8 * i + (lane >> 3)) * 33 + 4 * (lane & 7); q[0] = tv[i][0]; q[1] = tv[i][1]; q[2] = tv[i][2]; q[3] = tv[i][3]; }
    LDS_WAIT(); asm volatile("" ::: "memory");
    if (d.kind == 0) { bf16* WT = (bf16*)d.dst;
#pragma unroll
        for (int j = 0; j < 8; ++j) { const int c = (lane >> 3) + 8 * (j & 1), n = (lane & 7) + 8 * (j >> 1); const LAS float* s = scr + (8 * c) * 33 + n;
            u32x4 o; o.x = cvt_pk_bf16(s[0 * 33], s[1 * 33]); o.y = cvt_pk_bf16(s[2 * 33], s[3 * 33]); o.z = cvt_pk_bf16(s[4 * 33], s[5 * 33]); o.w = cvt_pk_bf16(s[6 * 33], s[7 * 33]);
            st16(WT + (size_t)n * d.K + 8 * c, o); }
    } else { const float sc = d.sc; const int c = lane & 7;
#pragma unroll
        for (int j = 0; j < 4; ++j) { const int n = (lane >> 3) + 8 * j; const LAS float* s = scr + (16 * c) * 33 + n;
            u32x4 o; o.x = pk4_fp8(s[0 * 33] * sc, s[1 * 33] * sc, s[2 * 33] * sc, s[3 * 33] * sc); o.y = pk4_fp8(s[4 * 33] * sc, s[5 * 33] * sc, s[6 * 33] * sc, s[7 * 33] * sc);
            o.z = pk4_fp8(s[8 * 33] * sc, s[9 * 33] * sc, s[10 * 33] * sc, s[11 * 33] * sc); o.w = pk4_fp8(s[12 * 33] * sc, s[13 * 33] * sc, s[14 * 33] * sc, s[15 * 33] * sc);
            st16(d.dst + (size_t)n * d.K + 16 * c, o); } }
    LDS_WAIT(); asm volatile("" ::: "memory");
}
__device__ __forceinline__ int gu_row(int n, int F) { const int up = n >= F, j = up ? n - F : n; return (j >> 7) * 256 + up * 128 + (j & 127); }
struct Ptrs {
    const float* in[24]; float* out; unsigned char* ws; int ph_lo, ph_hi;
};
__device__ __forceinline__ unsigned long long p_prologue(const Ctx& C, const Ptrs& P) {
    unsigned long long pr_sub = 0ull;
    LAS float* scr = (LAS float*)(C.lds + C.wave * 16896);
    const int gw = C.wg * 8 + C.wave, NGW = C.G * 8;
    unsigned char* ws = P.ws;
    constexpr int I1 = 16 * 128, I2 = 4 * 32, I3 = 16 * 64, I4 = 16 * 352, I5 = 44 * 64, I6 = 16 * 128, I7 = 16 * 64, I8 = 8 * 16 * 88, I9 = 8 * 12 * 64;
    constexpr int NITEMS = I1 + I2 + I3 + I4 + I5 + I6 + I7 + I8 + I9;
    auto item = [&](int it, TrDesc& d) {
        d.kind = 2; d.sc = 1.0f; d.src = nullptr; d.dst = nullptr; d.N = 0; d.K = 0;
        if (it >= NITEMS) return;
        int r = it;
        auto bf = [&](const float* W, int K, int N, bf16* WT, int drow, int k0, int n0) { d.kind = 0; d.src = W + (size_t)k0 * N + n0; d.N = N; d.dst = (unsigned char*)(WT + (size_t)drow * K + k0); d.K = K; };
        auto f8 = [&](const float* W, int K, int N, unsigned char* WT, int drow, int k0, int n0, float sc) { d.kind = 1; d.sc = sc; d.src = W + (size_t)k0 * N + n0; d.N = N; d.dst = WT + (size_t)drow * K + k0; d.K = K; };
        if (r < I1) { const int kb = r / 128, nb = r % 128; bf(P.in[1], DM, EVEN_IN, (bf16*)(ws + WS_WIN0), 32 * nb, 128 * kb, 32 * nb); return; } r -= I1;
        if (r < I2) { const float* pw = P.in[2] + (size_t)r * 2048; const float* sc = P.in[3] + 256 * (r >> 5); bf16* o = (bf16*)(ws + WS_PW) + (size_t)r * 2048;
#pragma unroll
            for (int i = 0; i < 8; ++i) { const f32x4 a = *(const f32x4*)(pw + 256 * i + 4 * C.lane), b = *(const f32x4*)(sc + 4 * C.lane); u32x2 w; w.x = cvt_pk_bf16(a[0] * b[0], a[1] * b[1]); w.y = cvt_pk_bf16(a[2] * b[2], a[3] * b[3]); *(u32x2*)(o + 256 * i + 4 * C.lane) = w; }
            return; } r -= I2;
        if (r < I3) { const int kb = r / 64, nb = r % 64;
            if (kb < 8) bf(P.in[4], 1024, DM, (bf16*)(ws + WS_WTMP), 32 * nb, 128 * kb, 32 * nb);
            else bf(P.in[4], DM, DM, (bf16*)(ws + WS_WOUT0), 32 * nb, 128 * kb, 32 * nb);
            return; } r -= I3;
        if (r < I4) { const int kb = r / 352, nb = r % 352; f8(P.in[7], DM, 2 * FFN, ws + WS_WGU, gu_row(32 * nb, FFN), 128 * kb, 32 * nb, S8_W1); return; } r -= I4;
        if (r < I5) { const int kb = r / 64, nb = r % 64; f8(P.in[8], FFN, DM, ws + WS_WDN, 32 * nb, 128 * kb, 32 * nb, S8_W2); return; } r -= I5;
        if (r < I6) { const int kb = r / 128, nb = r % 128; bf(P.in[11], DM, 4096, (bf16*)(ws + WS_WIN1), 32 * nb, 128 * kb, 32 * nb); return; } r -= I6;
        if (r < I7) { const int kb = r / 64, nb = r % 64; bf(P.in[16], DM, DM, (bf16*)(ws + WS_WOUT1), 32 * nb, 128 * kb, 32 * nb); return; } r -= I7;
        if (r < I8) { const int e = r / (16 * 88), q = r % (16 * 88), kb = q / 88, nb = q % 88;
            f8(P.in[20] + (size_t)e * DM * 2 * EDIM, DM, 2 * EDIM, ws + WS_MGU + (size_t)e * 2 * EDIM * DM, gu_row(32 * nb, EDIM), 128 * kb, 32 * nb, S8_W1); return; } r -= I8;
        { const int e = r / (12 * 64), q = r % (12 * 64), kb = q / 64, nb = q % 64; unsigned char* wt = ws + WS_MDN + (size_t)e * DM * EPAD;
            if (kb < 11) f8(P.in[21] + (size_t)e * EDIM * DM, EPAD, DM, wt, 32 * nb, 128 * kb, 32 * nb, S8_W2);
            else { const int n = C.lane >> 1, hf = C.lane & 1; const u32x4 z = {0u, 0u, 0u, 0u};
                unsigned char* zp = wt + (size_t)(32 * nb + n) * EPAD + 128 * kb + 64 * hf; st16(zp, z); st16(zp + 16, z); st16(zp + 32, z); st16(zp + 48, z); } }
    };
    for (int it = gw; it < NITEMS; it += 2 * NGW) {
        TrDesc d0, d1; f32x4 t0[16], t1[16];
        item(it, d0); tr_load(d0, t0, C.lane);
        item(it + NGW, d1); tr_load(d1, t1, C.lane);
        tr_process(d0, t0, scr, C.lane); tr_process(d1, t1, scr, C.lane);
    }
    if (MK_PROBE_SUB) pr_sub = __builtin_amdgcn_s_memrealtime();
    { unsigned long long* lx = (unsigned long long*)(ws + WS_LNX);
        for (size_t i = (size_t)C.wg * 512 + C.tid; i < (size_t)(3 * 2 * MiB / 8); i += (size_t)C.G * 512) __hip_atomic_store(lx + i, 0ull, __ATOMIC_RELAXED, __HIP_MEMORY_SCOPE_AGENT); }
    const float* x = P.in[0]; bf16* XB = (bf16*)(ws + WS_XB);
    const size_t nch = (size_t)M * DM / 512; const int gwv = C.wg * 8 + C.wave;
#pragma unroll 4
    for (size_t ch = gwv; ch < nch; ch += (size_t)C.G * 8) {
        const float* xp = x + ch * 512 + 4 * C.lane; const f32x4 a = *(const f32x4*)xp, b = *(const f32x4*)(xp + 256);
        u32x2 wa, wb; wa.x = cvt_pk_bf16(a[0], a[1]); wa.y = cvt_pk_bf16(a[2], a[3]); wb.x = cvt_pk_bf16(b[0], b[1]); wb.y = cvt_pk_bf16(b[2], b[3]);
        bf16* op = XB + ch * 512 + 4 * C.lane; st8(op, wa); st8(op + 256, wb);
    }
    __syncthreads();
    for (int u = C.tid; u < 1024; u += 512) if (MK_PROBE_HI < 0 || u < 106 || u > 109) ((LAS unsigned*)(C.lds + RING_BYTES))[u] = 0u;
    __syncthreads();
    return pr_sub;
}

template <int W> __device__ __forceinline__ void pooldiff_group(const Ctx& C, const bf16* PROJ, bf16* D, int g) {
    const size_t nitems = (size_t)M * 32, stride = (size_t)C.G * 512;
    for (size_t it = (size_t)C.wg * 512 + C.tid; it < nitems; it += stride) {
        const int row = (int)(it >> 5), c32 = (int)(it & 31), t = row & (SEQ - 1);
        const bf16* p = PROJ + (size_t)row * 4096 + g * 256 + c32 * 8;
        u32x4 v[W];
#pragma unroll
        for (int j = 0; j < W; ++j) { const int jj = j < t ? j : t; v[j] = *(const u32x4*)(p - (size_t)jj * 4096); }
        float s[8] = {bf_lo(v[0].x), bf_hi(v[0].x), bf_lo(v[0].y), bf_hi(v[0].y), bf_lo(v[0].z), bf_hi(v[0].z), bf_lo(v[0].w), bf_hi(v[0].w)};
        float o[8];
#pragma unroll
        for (int k = 0; k < 8; ++k) o[k] = s[k];
#pragma unroll
        for (int j = 1; j < W; ++j) { const float m = (j <= t) ? 1.0f : 0.0f;
            s[0] += m * bf_lo(v[j].x); s[1] += m * bf_hi(v[j].x); s[2] += m * bf_lo(v[j].y); s[3] += m * bf_hi(v[j].y); s[4] += m * bf_lo(v[j].z); s[5] += m * bf_hi(v[j].z); s[6] += m * bf_lo(v[j].w); s[7] += m * bf_hi(v[j].w); }
        const float inv = 1.0f / (float)((t + 1) < W ? (t + 1) : W);
#pragma unroll
        for (int k = 0; k < 8; ++k) o[k] = s[k] * inv - o[k];
        u32x4 wv; wv.x = cvt_pk_bf16(o[0], o[1]); wv.y = cvt_pk_bf16(o[2], o[3]); wv.z = cvt_pk_bf16(o[4], o[5]); wv.w = cvt_pk_bf16(o[6], o[7]);
        st16(D + (size_t)row * DM + g * 256 + c32 * 8, wv);
    }
}
__device__ __forceinline__ void p_pooldiff(const Ctx& C, const bf16* PROJ, bf16* D) {
    pooldiff_group<2>(C, PROJ, D, 0); pooldiff_group<4>(C, PROJ, D, 1); pooldiff_group<8>(C, PROJ, D, 2); pooldiff_group<16>(C, PROJ, D, 3);
}

__device__ __forceinline__ void p_attention(const Ctx& C, const bf16* PROJ, bf16* MIX) {
    constexpr int KP = 136, VP = 68;
    LAS bf16* Ks = (LAS bf16*)C.lds;
    LAS bf16* Vt = (LAS bf16*)(C.lds + 2 * 64 * KP * 2);
    volatile LAS int* flg = (volatile LAS int*)(C.lds + 2 * 64 * KP * 2 + 2 * 128 * VP * 2);
    const int lane = C.lane, w = C.wave, r = lane & 31, h = lane >> 5, tid = C.tid;
    const int rp = 16 * ((r >> 2) & 1) + 4 * (r >> 3) + (r & 3);
    constexpr float SC2 = 0.08838834764831845f * 1.4426950408889634f;
    constexpr float RDONE = 1.0e-37f;
    for (int ui = C.wg; ui < 1024; ui += C.G) {
        const int bh = ui & 15, qb = ui >> 4, b = bh >> 3, hd = bh & 7;
        const size_t rowbase = (size_t)b * SEQ;
        const int tw0 = qb * 256 + w * 32;
        bf16x8 qf[8];
        { const bf16* qp = PROJ + (rowbase + tw0 + r) * 4096 + 1024 + hd * 128 + 8 * h;
#pragma unroll
          for (int st = 0; st < 8; ++st) qf[st] = *(const bf16x8*)(qp + 16 * st); }
        f32x16 O[4];
#pragma unroll
        for (int d = 0; d < 4; ++d)
#pragma unroll
            for (int i = 0; i < 16; ++i) O[d][i] = 0.f;
        float R = 1.0f; bool wdone = false;
        const int kt_hi = qb * 4 + 3;
        u32x4 kreg[2], vreg[2];
#define ATT_LOAD(kt) do { _Pragma("unroll") for (int _i = 0; _i < 2; ++_i) { const int _c = tid + 512 * _i; \
            kreg[_i] = *(const u32x4*)(PROJ + (rowbase + 64 * (kt) + (_c >> 4)) * 4096 + 2048 + hd * 128 + 8 * (_c & 15)); \
            vreg[_i] = *(const u32x4*)(PROJ + (rowbase + 64 * (kt) + lane) * 4096 + 3072 + hd * 128 + 8 * (w + 8 * _i)); } } while (0)
#define ATT_STORE(buf) do { _Pragma("unroll") for (int _i = 0; _i < 2; ++_i) { const int _c = tid + 512 * _i; \
            *(LAS u32x4*)(Ks + (buf) * 64 * KP + (_c >> 4) * KP + 8 * (_c & 15)) = kreg[_i]; \
            LAS bf16* _vp = Vt + (buf) * 128 * VP + (8 * (w + 8 * _i)) * VP + lane; const u32x4 _v = vreg[_i]; \
            _vp[0 * VP] = (bf16)(_v.x & 0xffff); _vp[1 * VP] = (bf16)(_v.x >> 16); _vp[2 * VP] = (bf16)(_v.y & 0xffff); _vp[3 * VP] = (bf16)(_v.y >> 16); \
            _vp[4 * VP] = (bf16)(_v.z & 0xffff); _vp[5 * VP] = (bf16)(_v.z >> 16); _vp[6 * VP] = (bf16)(_v.w & 0xffff); _vp[7 * VP] = (bf16)(_v.w >> 16); } } while (0)
        ATT_LOAD(kt_hi); ATT_STORE(0);
        __syncthreads();
        for (int kt = kt_hi, it = 0; ; --kt, ++it) {
            const int buf = it & 1; const bool more = kt > 0;
            if (more) ATT_LOAD(kt - 1);
            if (!wdone) {
#pragma unroll
                for (int sub = 1; sub >= 0; --sub) {
                    if (64 * kt + 32 * sub <= tw0 + 30) {
                        f32x16 acc;
#pragma unroll
                        for (int i = 0; i < 16; ++i) acc[i] = 0.f;
                        const LAS bf16* kp = Ks + buf * 64 * KP + (32 * sub + r) * KP + 8 * h;
                        bf16x8 kf[8];
#pragma unroll
                        for (int st = 0; st < 8; ++st) kf[st] = *(const LAS bf16x8*)(kp + 16 * st);
                        asm volatile("s_waitcnt lgkmcnt(0)" ::: "memory"); __builtin_amdgcn_sched_barrier(0);
#pragma unroll
                        for (int st = 0; st < 8; ++st) acc = __builtin_amdgcn_mfma_f32_32x32x16_bf16(kf[st], qf[st], acc, 0, 0, 0);
                        __builtin_amdgcn_sched_barrier(0);
                        bf16x8 vf[4][2];
#pragma unroll
                        for (int dt = 0; dt < 4; ++dt)
#pragma unroll
                            for (int s2 = 0; s2 < 2; ++s2) { const LAS bf16* vp = Vt + buf * 128 * VP + (32 * dt + rp) * VP + 32 * sub + 16 * s2 + 4 * h;
                                const bf16x4 lo = *(const LAS bf16x4*)vp, hi = *(const LAS bf16x4*)(vp + 8);
                                vf[dt][s2] = (bf16x8){lo[0], lo[1], lo[2], lo[3], hi[0], hi[1], hi[2], hi[3]}; }
                        __builtin_amdgcn_sched_barrier(0);
                        const int key0 = 64 * kt + 32 * sub + 4 * h, query = tw0 + r;
                        float E[16], D0[4], L1[4], L2[4], IV[4];
#pragma unroll
                        for (int i = 0; i < 16; i += 2) { const f32x2 z2 = (f32x2){acc[i], acc[i + 1]} * (f32x2){SC2, SC2};
                            E[i] = __builtin_amdgcn_exp2f(fminf(z2[0], 20.0f)); E[i + 1] = __builtin_amdgcn_exp2f(fminf(z2[1], 20.0f)); }
                        if (64 * kt + 32 * sub + 31 >= tw0) { const int lim = query - key0;
#pragma unroll
                            for (int i = 0; i < 16; ++i) E[i] = ((i & 3) + 8 * (i >> 2) < lim) ? E[i] : 0.0f; }
                        float T[4], PGm[4];
#pragma unroll
                        for (int g = 0; g < 4; ++g) { const float d0 = 1.0f + E[4 * g], d1 = 1.0f + E[4 * g + 1], d2 = 1.0f + E[4 * g + 2], d3 = 1.0f + E[4 * g + 3];
                            const float l1 = d0 * d1, l2 = l1 * d2, Gs = __builtin_amdgcn_rcpf(l2 * d3); D0[g] = d0; L1[g] = l1; L2[g] = l2; IV[g] = Gs;
                            const auto rr = __builtin_amdgcn_permlane32_swap(__float_as_uint(Gs), __float_as_uint(Gs), false, false);
                            const float lo = __uint_as_float(rr[0]), hi = __uint_as_float(rr[1]);
                            T[g] = lo * hi; PGm[g] = (h == 0) ? hi : 1.0f; }
                        float SG[4]; SG[3] = 1.0f; SG[2] = T[3]; SG[1] = T[3] * T[2]; SG[0] = SG[1] * T[1];
                        const float total = SG[0] * T[0];
                        float a[16];
#pragma unroll
                        for (int g = 0; g < 4; ++g) { const float t0 = (R * SG[g] * PGm[g]) * IV[g];
                            const f32x2 a01 = (f32x2){E[4 * g + 0], E[4 * g + 1]} * (f32x2){t0, t0 * D0[g]}, a23 = (f32x2){E[4 * g + 2], E[4 * g + 3]} * ((f32x2){L1[g], L2[g]} * (f32x2){t0, t0});
                            a[4 * g + 0] = a01[0]; a[4 * g + 1] = a01[1]; a[4 * g + 2] = a23[0]; a[4 * g + 3] = a23[1]; }
                        R *= total;
                        bf16x8 pb[2];
#pragma unroll
                        for (int s = 0; s < 2; ++s) { u32x4 wv; wv.x = cvt_pk_bf16(a[8 * s + 0], a[8 * s + 1]); wv.y = cvt_pk_bf16(a[8 * s + 2], a[8 * s + 3]); wv.z = cvt_pk_bf16(a[8 * s + 4], a[8 * s + 5]); wv.w = cvt_pk_bf16(a[8 * s + 6], a[8 * s + 7]);
                            pb[s] = __builtin_bit_cast(bf16x8, wv); }
                        asm volatile("s_waitcnt lgkmcnt(0)" ::: "memory"); __builtin_amdgcn_sched_barrier(0);
#pragma unroll
                        for (int dt = 0; dt < 4; ++dt)
#pragma unroll
                            for (int s = 0; s < 2; ++s) O[dt] = __builtin_amdgcn_mfma_f32_32x32x16_bf16(vf[dt][s], pb[s], O[dt], 0, 0, 0);
                        __builtin_amdgcn_sched_barrier(0);
                    }
                }
                wdone = __all(R < RDONE);
            }
            if (more) ATT_STORE(buf ^ 1);
            if (lane == 0) flg[buf * 8 + w] = wdone ? 1 : 0;
            __syncthreads();
            if (!more) break;
            int alld = 1;
#pragma unroll
            for (int j = 0; j < 8; ++j) alld &= flg[buf * 8 + j];
            if (alld) break;
        }
#undef ATT_LOAD
#undef ATT_STORE
        bf16* op = MIX + (rowbase + tw0 + r) * DM + 1024 + hd * 128 + 16 * h;
#pragma unroll
        for (int dt = 0; dt < 4; ++dt)
#pragma unroll
            for (int hv = 0; hv < 2; ++hv) { const int i0 = 8 * hv; u32x4 wv; wv.x = cvt_pk_bf16(O[dt][i0], O[dt][i0 + 1]); wv.y = cvt_pk_bf16(O[dt][i0 + 2], O[dt][i0 + 3]); wv.z = cvt_pk_bf16(O[dt][i0 + 4], O[dt][i0 + 5]); wv.w = cvt_pk_bf16(O[dt][i0 + 6], O[dt][i0 + 7]);
                st16(op + 32 * dt + 8 * hv, wv); }
        __syncthreads();
    }
}

template <bool OUT_F32, bool ROUTE, bool W8 = false, bool PRE = false>
__device__ __forceinline__ void p_layernorm(const Ctx& C, const bf16* Tin, const float* gam, const float* bet, bf16* XBo, float* outf, unsigned char* X8o, const float* wr_, unsigned* cnt, int* list, float* gates, int* ppos = nullptr) {
    LAS float* WrT = (LAS float*)C.lds;
    LAS int* rec = (LAS int*)(C.lds + 65536);
    const int lane = C.lane;
    if (ROUTE) { for (int i = C.tid; i < DM * 8; i += 512) { const int c = i >> 3, e = i & 7; WrT[e * DM + c] = wr_[i]; } __syncthreads(); }
    f32x4 gv[8], bv[8];
#pragma unroll
    for (int j = 0; j < 4; ++j) { if (PRE) { gv[2 * j] = gv[2 * j + 1] = bv[2 * j] = bv[2 * j + 1] = (f32x4){0.f, 0.f, 0.f, 0.f}; continue; }
        gv[2 * j] = *(const f32x4*)(gam + 512 * j + 8 * lane); gv[2 * j + 1] = *(const f32x4*)(gam + 512 * j + 8 * lane + 4);
        bv[2 * j] = *(const f32x4*)(bet + 512 * j + 8 * lane); bv[2 * j + 1] = *(const f32x4*)(bet + 512 * j + 8 * lane + 4); }
    const int rows_per = (M + C.G - 1) / C.G, row_lo = C.wg * rows_per, row_hi = (row_lo + rows_per) < M ? (row_lo + rows_per) : M;
#pragma unroll 2
    for (int row = row_lo + C.wave; row < row_hi; row += 8) {
        const bf16* xr = Tin + (size_t)row * DM + 8 * lane;
        f32x4 v[8]; float s = 0.f;
#pragma unroll
        for (int j = 0; j < 4; ++j) { const u32x4 r = *(const u32x4*)(xr + 512 * j);
            v[2 * j] = (f32x4){bf_lo(r.x), bf_hi(r.x), bf_lo(r.y), bf_hi(r.y)}; v[2 * j + 1] = (f32x4){bf_lo(r.z), bf_hi(r.z), bf_lo(r.w), bf_hi(r.w)}; }
#pragma unroll
        for (int j = 0; j < 8; ++j) s += (v[j][0] + v[j][1]) + (v[j][2] + v[j][3]);
        if (!PRE) {
        const float mean = wave_sum(s) * (1.0f / DM); float q = 0.f;
#pragma unroll
        for (int j = 0; j < 8; ++j) { v[j] = v[j] - mean; q += (v[j][0] * v[j][0] + v[j][1] * v[j][1]) + (v[j][2] * v[j][2] + v[j][3] * v[j][3]); }
        const float rstd = 1.0f / sqrtf(wave_sum(q) * (1.0f / DM) + LN_EPS);
#pragma unroll
        for (int j = 0; j < 8; ++j) v[j] = v[j] * rstd * gv[j] + bv[j];
        }
        if (PRE) {} else if (OUT_F32) { float* o = outf + (size_t)row * DM + 8 * lane;
#pragma unroll
            for (int j = 0; j < 4; ++j) { st16f(o + 512 * j, v[2 * j]); st16f(o + 512 * j + 4, v[2 * j + 1]); } }
        else { bf16* xb = XBo + (size_t)row * DM + 8 * lane;
#pragma unroll
            for (int j = 0; j < 4; ++j) { u32x4 wv; wv.x = cvt_pk_bf16(v[2 * j][0], v[2 * j][1]); wv.y = cvt_pk_bf16(v[2 * j][2], v[2 * j][3]); wv.z = cvt_pk_bf16(v[2 * j + 1][0], v[2 * j + 1][1]); wv.w = cvt_pk_bf16(v[2 * j + 1][2], v[2 * j + 1][3]);
                st16(xb + 512 * j, wv); }
            if (W8) { unsigned char* x8 = X8o + (size_t)row * DM + 8 * lane;
#pragma unroll
                for (int j = 0; j < 4; ++j) { u32x2 wv; wv.x = pk4_fp8(v[2 * j][0] * S8_X, v[2 * j][1] * S8_X, v[2 * j][2] * S8_X, v[2 * j][3] * S8_X); wv.y = pk4_fp8(v[2 * j + 1][0] * S8_X, v[2 * j + 1][1] * S8_X, v[2 * j + 1][2] * S8_X, v[2 * j + 1][3] * S8_X);
                    st8(x8 + 512 * j, wv); } } }
        if (ROUTE) {
            float lg[8];
#pragma unroll
            for (int e = 0; e < 8; ++e) { float a = 0.f;
#pragma unroll
                for (int j = 0; j < 4; ++j) { const f32x4 w0 = *(const LAS f32x4*)(WrT + e * DM + 512 * j + 8 * lane), w1 = *(const LAS f32x4*)(WrT + e * DM + 512 * j + 8 * lane + 4);
                    a += (v[2 * j][0] * w0[0] + v[2 * j][1] * w0[1]) + (v[2 * j][2] * w0[2] + v[2 * j][3] * w0[3]) + (v[2 * j + 1][0] * w1[0] + v[2 * j + 1][1] * w1[1]) + (v[2 * j + 1][2] * w1[2] + v[2 * j + 1][3] * w1[3]); }
                lg[e] = wave_sum(a); }
            int e0 = 0; float v0 = lg[0];
#pragma unroll
            for (int e = 1; e < 8; ++e) if (lg[e] > v0) { v0 = lg[e]; e0 = e; }
            int e1 = -1; float v1 = -3.0e38f;
#pragma unroll
            for (int e = 0; e < 8; ++e) if (e != e0 && lg[e] > v1) { v1 = lg[e]; e1 = e; }
            const float g0 = 1.0f / (1.0f + __expf(v1 - v0)), g1 = 1.0f - g0;
            if (lane == 0) { LAS int* rc = rec + (row - row_lo) * 4; rc[0] = e0; rc[1] = e1; rc[2] = __float_as_int(g0); rc[3] = __float_as_int(g1); }
        }
    }
    if (ROUTE) {
        __syncthreads();
        if (C.tid < 16) {
            const int g = C.tid, nrow = row_hi - row_lo; int n = 0;
            for (int i = 0; i < nrow; ++i) n += ((rec[i * 4] == g) ? 1 : 0) + ((rec[i * 4 + 1] == g) ? 1 : 0);
            if (n > 0) { int pos = (int)__hip_atomic_fetch_add(cnt + g, (unsigned)n, RLX_AGENT);
                for (int i = 0; i < nrow; ++i)
                    for (int slot = 0; slot < 2; ++slot) if (rec[i * 4 + slot] == g) { list[g * LISTCAP + pos] = row_lo + i; gates[g * LISTCAP + pos] = __int_as_float(rec[i * 4 + 2 + slot]); ppos[(row_lo + i) * 2 + slot] = (g << 15) | pos; ++pos; } }
        }
        __syncthreads();
    }
}

__device__ __forceinline__ void p_router(const Ctx& C, const bf16* Hin, const float* wr_, unsigned* cnt, int* list, float* gates, int* ppos) {
    constexpr int WPT = 2056;
    LAS bf16* Wh = (LAS bf16*)C.lds; LAS bf16* Wl = Wh + 8 * WPT;
    LAS float* LG = (LAS float*)(C.lds + 2 * 8 * WPT * 2);
    LAS int* rec = (LAS int*)(C.lds + 2 * 8 * WPT * 2 + 4096);
    const int lane = C.lane, w = C.wave, r16 = lane & 15, q = lane >> 4;
    { f32x4 w4[8];
#pragma unroll
      for (int k = 0; k < 8; ++k) w4[k] = *(const f32x4*)(wr_ + 4 * (C.tid + 512 * k));
#pragma unroll
      for (int k = 0; k < 8; ++k) { const int i0 = 4 * (C.tid + 512 * k), c = i0 >> 3, e0 = i0 & 7;
#pragma unroll
          for (int j = 0; j < 4; ++j) { const float x = w4[k][j]; const unsigned hb = cvt_pk_bf16(x, 0.f) & 0xffff; const float lo = x - __uint_as_float(hb << 16);
              Wh[(e0 + j) * WPT + c] = (bf16)hb; Wl[(e0 + j) * WPT + c] = (bf16)(cvt_pk_bf16(lo, 0.f) & 0xffff); } } }
    __syncthreads();
    const int rows_per = (M + C.G - 1) / C.G, row_lo = C.wg * rows_per, row_hi = (row_lo + rows_per) < M ? (row_lo + rows_per) : M;
    for (int rb = 0; rb < rows_per; rb += 128) {
        int myrow = row_lo + rb + 16 * w + r16; if (myrow >= row_hi) myrow = row_hi - 1;
        const bf16* ap = Hin + (size_t)myrow * DM + 8 * q; const LAS bf16* bh = Wh + (r16 & 7) * WPT + 8 * q; const LAS bf16* bl = Wl + (r16 & 7) * WPT + 8 * q;
        f32x4 a0 = {0.f, 0.f, 0.f, 0.f}, a1 = {0.f, 0.f, 0.f, 0.f};
        for (int k0 = 0; k0 < 64; k0 += 8) { bf16x8 af[8];
#pragma unroll
            for (int k = 0; k < 8; ++k) af[k] = *(const bf16x8*)(ap + 32 * (k0 + k));
#pragma unroll
            for (int k = 0; k < 8; ++k) { const bf16x8 h8 = *(const LAS bf16x8*)(bh + 32 * (k0 + k)), l8 = *(const LAS bf16x8*)(bl + 32 * (k0 + k));
                a0 = __builtin_amdgcn_mfma_f32_16x16x32_bf16(af[k], h8, a0, 0, 0, 0); a1 = __builtin_amdgcn_mfma_f32_16x16x32_bf16(af[k], l8, a1, 0, 0, 0); } }
        a0 = a0 + a1;
        if (r16 < 8) {
#pragma unroll
            for (int e = 0; e < 4; ++e) LG[(16 * w + 4 * q + e) * 8 + r16] = a0[e]; }
        __syncthreads();
        if (C.tid < 128 && row_lo + rb + C.tid < row_hi) { const f32x4 la = *(const LAS f32x4*)(LG + C.tid * 8), lb = *(const LAS f32x4*)(LG + C.tid * 8 + 4);
            const float lg[8] = {la[0], la[1], la[2], la[3], lb[0], lb[1], lb[2], lb[3]};
            int e0 = 0; float v0 = lg[0];
#pragma unroll
            for (int e = 1; e < 8; ++e) if (lg[e] > v0) { v0 = lg[e]; e0 = e; }
            int e1 = -1; float v1 = -3.0e38f;
#pragma unroll
            for (int e = 0; e < 8; ++e) if (e != e0 && lg[e] > v1) { v1 = lg[e]; e1 = e; }
            const float g0 = 1.0f / (1.0f + __expf(v1 - v0)), g1 = 1.0f - g0;
            LAS int* rc = rec + (rb + C.tid) * 4; rc[0] = e0; rc[1] = e1; rc[2] = __float_as_int(g0); rc[3] = __float_as_int(g1); }
        __syncthreads();
    }
    if (rows_per == 128 && row_hi - row_lo == 128) {
        LAS int* cw = rec + 4 * 128;
        int gid[2] = {0, 0}, rk[2] = {0, 0}; float gt[2] = {0.f, 0.f};
        if (C.tid < 128) { const LAS int* rc = rec + C.tid * 4; gid[0] = rc[0]; gid[1] = rc[1]; gt[0] = __int_as_float(rc[2]); gt[1] = __int_as_float(rc[3]);
            const unsigned long long below = (1ull << lane) - 1ull;
#pragma unroll
            for (int g = 0; g < 8; ++g) { const unsigned long long m0 = __ballot(gid[0] == g), m1 = __ballot(gid[1] == g);
                if (gid[0] == g) rk[0] = __popcll(m0 & below);
                if (gid[1] == g) rk[1] = __popcll(m0) + __popcll(m1 & below);
                if (lane == 0) { cw[w * 16 + g] = __popcll(m0) + __popcll(m1); cw[w * 16 + 8 + g] = 0; } } }
        __syncthreads();
        if (C.tid < 16) { const int n0 = cw[C.tid], n1 = cw[16 + C.tid]; const int n = n0 + n1;
            cw[32 + C.tid] = n > 0 ? (int)__hip_atomic_fetch_add(cnt + C.tid, (unsigned)n, RLX_AGENT) : 0; }
        __syncthreads();
        if (C.tid < 128) {
#pragma unroll
            for (int sl = 0; sl < 2; ++sl) { const int g = gid[sl], pos = cw[32 + g] + (w == 1 ? cw[g] : 0) + rk[sl];
                list[g * LISTCAP + pos] = row_lo + C.tid; gates[g * LISTCAP + pos] = gt[sl]; ppos[(row_lo + C.tid) * 2 + sl] = (g << 15) | pos; } }
    } else if (C.tid < 16) {
        const int g = C.tid, nrow = row_hi - row_lo; int n = 0;
        for (int i = 0; i < nrow; ++i) n += ((rec[i * 4] == g) ? 1 : 0) + ((rec[i * 4 + 1] == g) ? 1 : 0);
        if (n > 0) { int pos = (int)__hip_atomic_fetch_add(cnt + g, (unsigned)n, RLX_AGENT);
            for (int i = 0; i < nrow; ++i)
                for (int slot = 0; slot < 2; ++slot) if (rec[i * 4 + slot] == g) { list[g * LISTCAP + pos] = row_lo + i; gates[g * LISTCAP + pos] = __int_as_float(rec[i * 4 + 2 + slot]); ppos[(row_lo + i) * 2 + slot] = (g << 15) | pos; ++pos; } }
    }
    __syncthreads();
}

__device__ __forceinline__ void p_final_ln(const Ctx& C, const bf16* XBi, const bf16* OP, const int* ppos, const float* gam, const float* bet, float* outf) {
    const LAS int* tbase = (const LAS int*)(C.lds + TAB_OFF);
    const int lane = C.lane;
    f32x4 gv[8], bv[8];
#pragma unroll
    for (int j = 0; j < 4; ++j) { gv[2 * j] = *(const f32x4*)(gam + 512 * j + 8 * lane); gv[2 * j + 1] = *(const f32x4*)(gam + 512 * j + 8 * lane + 4);
        bv[2 * j] = *(const f32x4*)(bet + 512 * j + 8 * lane); bv[2 * j + 1] = *(const f32x4*)(bet + 512 * j + 8 * lane + 4); }
    const int rows_per = (M + C.G - 1) / C.G, row_lo = C.wg * rows_per, row_hi = (row_lo + rows_per) < M ? (row_lo + rows_per) : M;
    for (int rb = row_lo + C.wave; rb < row_hi; rb += 8 * 64) {
      const int myrow = rb + 8 * lane; int q0 = 0, q1 = 0;
      if (myrow < row_hi) { const u32x2 pp = *(const u32x2*)(ppos + (size_t)myrow * 2); q0 = (int)pp.x; q1 = (int)pp.y; }
      const int r0v = tbase[q0 >> 15] + (q0 & 32767), r1v = tbase[q1 >> 15] + (q1 & 32767);
      const int nrow = (row_hi - rb + 7) / 8 < 64 ? (row_hi - rb + 7) / 8 : 64;
      for (int i = 0; i < nrow; ++i) { const int row = rb + 8 * i;
        const size_t r0 = (size_t)__builtin_amdgcn_readlane(r0v, i), r1 = (size_t)__builtin_amdgcn_readlane(r1v, i);
        const bf16* xr = XBi + (size_t)row * DM + 8 * lane; const bf16* o0 = OP + r0 * DM + 8 * lane; const bf16* o1 = OP + r1 * DM + 8 * lane;
        u32x4 a[4], b[4], c[4];
#pragma unroll
        for (int j = 0; j < 4; ++j) { a[j] = *(const u32x4*)(xr + 512 * j); b[j] = *(const u32x4*)(o0 + 512 * j); c[j] = *(const u32x4*)(o1 + 512 * j); }
        f32x4 v[8]; float s = 0.f;
#pragma unroll
        for (int j = 0; j < 4; ++j) {
            v[2 * j] = (f32x4){bf_lo(a[j].x), bf_hi(a[j].x), bf_lo(a[j].y), bf_hi(a[j].y)} * DN_ALPHA + ((f32x4){bf_lo(b[j].x), bf_hi(b[j].x), bf_lo(b[j].y), bf_hi(b[j].y)} + (f32x4){bf_lo(c[j].x), bf_hi(c[j].x), bf_lo(c[j].y), bf_hi(c[j].y)});
            v[2 * j + 1] = (f32x4){bf_lo(a[j].z), bf_hi(a[j].z), bf_lo(a[j].w), bf_hi(a[j].w)} * DN_ALPHA + ((f32x4){bf_lo(b[j].z), bf_hi(b[j].z), bf_lo(b[j].w), bf_hi(b[j].w)} + (f32x4){bf_lo(c[j].z), bf_hi(c[j].z), bf_lo(c[j].w), bf_hi(c[j].w)}); }
#pragma unroll
        for (int j = 0; j < 8; ++j) s += (v[j][0] + v[j][1]) + (v[j][2] + v[j][3]);
        const float mean = wave_sum(s) * (1.0f / DM); float q = 0.f;
#pragma unroll
        for (int j = 0; j < 8; ++j) { v[j] = v[j] - mean; q += (v[j][0] * v[j][0] + v[j][1] * v[j][1]) + (v[j][2] * v[j][2] + v[j][3] * v[j][3]); }
        const float rstd = 1.0f / sqrtf(wave_sum(q) * (1.0f / DM) + LN_EPS);
        float* o = outf + (size_t)row * DM + 8 * lane;
#pragma unroll
        for (int j = 0; j < 4; ++j) { st16f(o + 512 * j, v[2 * j] * rstd * gv[2 * j] + bv[2 * j]); st16f(o + 512 * j + 4, v[2 * j + 1] * rstd * gv[2 * j + 1] + bv[2 * j + 1]); }
      }
    }
}

__device__ __forceinline__ void p_sgu(const Ctx& C, const bf16* Z, bf16* SGo, const f32x2* vst, const float* sw, const float* sb, const float* lng, const float* lnb) {
    constexpr int WP = 136, NB = 16;
    LAS bf16* Ws = (LAS bf16*)C.lds;
    LAS bf16* vnT = (LAS bf16*)(C.lds + 128 * WP * 2);
    LAS f32x2* musr = (LAS f32x2*)(C.lds + 128 * WP * 2 + 256 * WP * 2);
    LAS float* bs = (LAS float*)(musr + NB * 128); LAS float* gm = bs + 128; LAS float* bt = gm + 256;
    const int lane = C.lane, w = C.wave, r = lane & 31, h = lane >> 5, tid = C.tid;
    const int rp = 16 * ((r >> 2) & 1) + 4 * (r >> 3) + (r & 3);
    const int sV = (lane & 31) + 32 * (w & 3), cV = (lane >> 5) + 2 * (w >> 2);
    int cur_g = -1;
    for (int ub = C.wg; ub < 2048; ub += NB * C.G) {
        int nb = (2048 - ub + C.G - 1) / C.G; if (nb > NB) nb = NB;
        __syncthreads();
        for (int idx = tid; idx < nb * 128; idx += 512) { const int u = ub + (idx >> 7) * C.G; const f32x2* p = vst + ((size_t)(u >> 3) * 128 + (idx & 127)) * 32; float s1 = 0.f, s2 = 0.f;
            f32x4 pv[16];
#pragma unroll
            for (int j = 0; j < 16; ++j) pv[j] = *(const f32x4*)(p + 2 * j);
#pragma unroll
            for (int j = 0; j < 16; ++j) { s1 += pv[j][0] + pv[j][2]; s2 += pv[j][1] + pv[j][3]; }
            const float mean = s1 * (1.0f / 2048.f), var = fmaxf(s2 * (1.0f / 2048.f) - mean * mean, 0.f);
            musr[idx] = (f32x2){mean, 1.0f / sqrtf(var + LN_EPS)}; }
        u32x4 vreg[8];
        { const int g0 = ub & 7; const size_t row0 = (size_t)(ub >> 3) * 128;
#pragma unroll
          for (int i = 0; i < 8; ++i) vreg[i] = *(const u32x4*)(Z + (row0 + sV) * 4096 + 2048 + g0 * 256 + 8 * (cV + 4 * i)); }
        for (int bi = 0; bi < nb; ++bi) {
            const int u = ub + bi * C.G, g = u & 7; const size_t row0 = (size_t)(u >> 3) * 128;
            if (g != cur_g) { cur_g = g; __syncthreads();
                { f32x4 wv4[8];
#pragma unroll
                  for (int k = 0; k < 8; ++k) wv4[k] = *(const f32x4*)(sw + (size_t)g * 16384 + 4 * (tid + 512 * k));
#pragma unroll
                  for (int k = 0; k < 8; ++k) { const int e = 4 * (tid + 512 * k), t = e >> 7, s2_ = e & 127; const f32x4 x = wv4[k];
                      u32x2 o; o.x = cvt_pk_bf16(s2_ <= t ? x[0] : 0.f, s2_ + 1 <= t ? x[1] : 0.f); o.y = cvt_pk_bf16(s2_ + 2 <= t ? x[2] : 0.f, s2_ + 3 <= t ? x[3] : 0.f);
                      *(LAS u32x2*)(Ws + t * WP + s2_) = o; } }
                if (tid < 128) bs[tid] = sb[g * 128 + tid];
                if (tid < 256) { gm[tid] = lng[g * 256 + tid]; bt[tid] = lnb[g * 256 + tid]; }
                __syncthreads(); }
            u32x4 ureg[4][2];
#pragma unroll
            for (int tt = 0; tt < 4; ++tt) { const bf16* up = Z + (row0 + 32 * tt + r) * 4096 + g * 256 + 32 * w + 16 * h; asm volatile("" : "+v"(up));
                ureg[tt][0] = *(const u32x4*)up; ureg[tt][1] = *(const u32x4*)(up + 8); }
            { const f32x2 ms = musr[bi * 128 + sV];
              const LAS float* gmp = gm + 8 * cV; const LAS float* btp = bt + 8 * cV; LAS bf16* dstb = vnT + (8 * cV) * WP + sV;
              asm volatile("" : "+v"(gmp), "+v"(btp), "+v"(dstb));
#pragma unroll
              for (int i = 0; i < 8; ++i) { const u32x4 v = vreg[i];
                float x[8] = {bf_lo(v.x), bf_hi(v.x), bf_lo(v.y), bf_hi(v.y), bf_lo(v.z), bf_hi(v.z), bf_lo(v.w), bf_hi(v.w)};
#pragma unroll
                for (int e = 0; e < 8; ++e) { const float y = (x[e] - ms[0]) * ms[1] * gmp[32 * i + e] + btp[32 * i + e]; dstb[(32 * i + e) * WP] = (bf16)(cvt_pk_bf16(y, 0.f) & 0xffff); }
                asm volatile("" ::: "memory"); } }
            if (bi + 1 < nb) { const int un = u + C.G, gn = un & 7; const size_t rown = (size_t)(un >> 3) * 128; const bf16* vp = Z + (rown + sV) * 4096 + 2048 + gn * 256 + 8 * cV; asm volatile("" : "+v"(vp));
#pragma unroll
                for (int i = 0; i < 8; ++i) vreg[i] = *(const u32x4*)(vp + 32 * i); }
            __syncthreads();
            f32x16 acc[4];
#pragma unroll
            for (int tt = 0; tt < 4; ++tt)
#pragma unroll
                for (int i = 0; i < 16; ++i) acc[tt][i] = 0.f;
#pragma unroll
            for (int ks = 0; ks < 8; ++ks) { const bf16x8 af = *(const LAS bf16x8*)(vnT + (32 * w + rp) * WP + 16 * ks + 8 * h);
#pragma unroll
                for (int tt = 0; tt < 4; ++tt) if (ks <= 2 * tt + 1) { const bf16x8 bfr = *(const LAS bf16x8*)(Ws + (32 * tt + r) * WP + 16 * ks + 8 * h);
                    acc[tt] = __builtin_amdgcn_mfma_f32_32x32x16_bf16(af, bfr, acc[tt], 0, 0, 0); }
                asm volatile("" ::: "memory"); }
            __syncthreads();
#pragma unroll
            for (int tt = 0; tt < 4; ++tt) { const int t = 32 * tt + r; const float bb = bs[t]; bf16* op = SGo + (row0 + t) * DM + g * 256 + 32 * w + 16 * h; asm volatile("" : "+v"(op));
#pragma unroll
                for (int hv = 0; hv < 2; ++hv) { const u32x4 uv = ureg[tt][hv]; const int i0 = 8 * hv;
                    u32x4 wv; wv.x = cvt_pk_bf16(bf_lo(uv.x) * (acc[tt][i0] + bb), bf_hi(uv.x) * (acc[tt][i0 + 1] + bb)); wv.y = cvt_pk_bf16(bf_lo(uv.y) * (acc[tt][i0 + 2] + bb), bf_hi(uv.y) * (acc[tt][i0 + 3] + bb));
                    wv.z = cvt_pk_bf16(bf_lo(uv.z) * (acc[tt][i0 + 4] + bb), bf_hi(uv.z) * (acc[tt][i0 + 5] + bb)); wv.w = cvt_pk_bf16(bf_lo(uv.w) * (acc[tt][i0 + 6] + bb), bf_hi(uv.w) * (acc[tt][i0 + 7] + bb));
                    st16(op + 8 * hv, wv); } }
        }
    }
    __syncthreads();
}

__device__ __forceinline__ void moe_tables(const Ctx& C, const unsigned* cnt) {
    LAS int* tbase = (LAS int*)(C.lds + TAB_OFF); LAS int* tcnt = tbase + 17; LAS unsigned char* tileg = (LAS unsigned char*)(tcnt + 16);
    __syncthreads();
    if (C.tid < 16) { int c = (int)__hip_atomic_load(cnt + C.tid, RLX_AGENT); if (c > LISTCAP) c = LISTCAP; tcnt[C.tid] = c; }
    __syncthreads();
    if (C.tid == 0) { int base = 0;
        for (int g = 0; g < 16; ++g) { tbase[g] = base; base += ((tcnt[g] + 255) >> 8) << 8; }
        tbase[16] = base; }
    __syncthreads();
    for (int t = C.tid; t < (tbase[16] >> 8); t += 512) { int g = 0;
#pragma unroll
        for (int k = 1; k < 16; ++k) g += (t * 256 >= tbase[k]) ? 1 : 0;
        tileg[t] = (unsigned char)g; }
    __syncthreads();
}

__global__ void __launch_bounds__(512, 2) fwd_kernel(Ptrs P) {
    extern __shared__ __attribute__((aligned(16))) unsigned char lds_raw[];
    Ctx C; C.lds = (LAS unsigned char*)lds_raw; C.tid = threadIdx.x; C.lane = C.tid & 63; C.wave = __builtin_amdgcn_readfirstlane(C.tid >> 6); C.G = gridDim.x; C.wg = blockIdx.x;
    unsigned char* ws = P.ws;
    unsigned* ctl = (unsigned*)(ws + WS_CTL);
    for (int u = C.tid; u < (LDS_BYTES - RING_BYTES) / 4; u += 512) ((LAS unsigned*)(C.lds + RING_BYTES))[u] = 0u;
    __syncthreads();
    XcdBarrier bar; bar.bar = ctl + CW_BAR; bar.x = 0; bar.st = nullptr;
    if (!MK_PER_PHASE) bar = xcd_barrier_post(ctl + CW_BAR, (volatile LAS unsigned*)(C.lds + MISC_OFF) + 8);
    if (!MK_PER_PHASE && C.tid == 0) __hip_atomic_store(ctl + CW_XCC + C.wg, 1u + xb_xcc_id(), __ATOMIC_RELAXED, __HIP_MEMORY_SCOPE_AGENT);
    const int lo = P.ph_lo, hi = P.ph_hi;
#ifndef PH_MASK
#define PH_MASK 0x1ffff
#endif
#define IN(k) (((PH_MASK >> (k)) & 1) && lo <= (k) && (k) < hi)
#ifndef REP_MASK
#define REP_MASK 0
#endif
#define REP(k) (1 + ((REP_MASK >> (k)) & 1))
#define SEAM(k) do { if (IN(k) && IN((k) + 1)) xcd_barrier(bar); if (MK_PROBE_HI >= 0 && (k) + 1 == MK_PROBE_LO) { if (C.tid == 0) PR_T0 = __builtin_amdgcn_s_memrealtime(); } if (MK_PROBE_HI >= 0 && (k) == MK_PROBE_HI) { if (C.tid == 0) PR_T1 = __builtin_amdgcn_s_memrealtime(); } } while (0)
#define PR_T0 (*(volatile LAS unsigned long long*)(C.lds + MISC_OFF + 104))
#define PR_T1 (*(volatile LAS unsigned long long*)(C.lds + MISC_OFF + 112))
    if (MK_PROBE_HI >= 0 && C.tid == 0) PR_T0 = __builtin_amdgcn_s_memrealtime();
#define XB ((bf16*)(ws + WS_XB))
#define TB ((bf16*)(ws + WS_TB))
#define OUT (P.out)
#define PROJ ((bf16*)(ws + WS_PROJ))
#define MIX ((bf16*)(ws + WS_MIX))
#define HID ((bf16*)(ws + WS_HID))
#define Zb ((bf16*)(ws + WS_Z))
#define SGb ((bf16*)(ws + WS_SG))
#define MHID ((bf16*)(ws + WS_MHID))
#define Dd ((bf16*)(ws + WS_D))
#define VST ((f32x2*)(ws + WS_VST))
#define LIST ((int*)(ws + WS_LIST))
#define GATE ((float*)(ws + WS_GATE))
#define CNT (ctl + CW_CNT)
    const LAS int* tbase = (const LAS int*)(C.lds + TAB_OFF); const LAS int* tcnt = tbase + 17; const LAS unsigned char* tileg = (const LAS unsigned char*)(tcnt + 16);

    if (IN(0)) for (int rep_ = 0; rep_ < REP(0); ++rep_) { const unsigned long long ps_ = p_prologue(C, P); if (MK_PROBE_SUB && C.tid == 0) PR_T1 = ps_; }
    if (!MK_PER_PHASE && IN(0) && IN(1) && C.wave == 0) { unsigned c_ = 0u, sp_ = 0u;
        for (;;) { c_ = (C.lane < 16) ? xb_ld(&bar.bar[XB_XCNT(C.lane)]) : 0u; unsigned s_ = c_;
#pragma unroll
            for (int o = 1; o < 16; o <<= 1) s_ += __shfl_xor(s_, o);
            if ((unsigned)__builtin_amdgcn_readfirstlane((int)s_) == gridDim.x) break;
            if (++sp_ > 4096u) break; __builtin_amdgcn_s_sleep(4); }
        if (sp_ <= 4096u) { const unsigned nx_ = (unsigned)__popcll(__ballot(c_ > 0u)), mine_ = (unsigned)__builtin_amdgcn_readlane((int)c_, (int)bar.x);
            if (C.lane == 0 && mine_ > 0u && nx_ > 0u) { bar.st[0] = mine_; bar.st[1] = nx_; } } }
    SEAM(0);
    if (IN(1)) for (int rep_ = 0; rep_ < REP(1); ++rep_) { pg8::Gemm g{XB, (const bf16*)(ws + WS_WIN0), DM, DM}; pg8::StaticOrder S; S.init(M, EVEN_IN, C.G, C.wg); pg8::EpiBf16 E{PROJ, 4096};
        pg8::gemm_phase<pg8::EpiBf16, pg8::StaticOrder, false>(C.lds, g, S, E);
        } SEAM(1);
    if (IN(2)) { for (int rep = 0; rep < REP(2); ++rep) {
        if (C.G > 64) {
            if (C.wg < 32) { int k256 = 256; asm volatile("" : "+s"(k256)); pg8::Gemm gf{(const bf16*)(ws + WS_WTMP), (const bf16*)(ws + WS_PW), k256, 1024}; pg8::FoldOrder Sf{C.wg}; pg8::EpiBf16 Ef{(bf16*)(ws + WS_WOUT0), DM};
                pg8::gemm_phase<pg8::EpiBf16, pg8::FoldOrder, false>(C.lds, gf, Sf, Ef); }
            else { Ctx C2 = C; C2.G = C.G - 32; C2.wg = C.wg - 32; p_pooldiff(C2, PROJ, MIX); }
        } else { int k256 = 256; asm volatile("" : "+s"(k256)); pg8::Gemm gf{(const bf16*)(ws + WS_WTMP), (const bf16*)(ws + WS_PW), k256, 1024}; pg8::FoldOrder Sf{C.wg}; pg8::EpiBf16 Ef{(bf16*)(ws + WS_WOUT0), DM};
            pg8::gemm_phase<pg8::EpiBf16, pg8::FoldOrder, false>(C.lds, gf, Sf, Ef); p_pooldiff(C, PROJ, MIX); }
        p_attention(C, PROJ, MIX); } } SEAM(2);
    int lnx_fast = 0;
    if (!MK_PER_PHASE && C.G == 256) { unsigned v_ = 0u;
        if (C.tid < 8) { const int cp = (C.wg & 7) + 8 * (8 * (C.wg >> 6) + C.tid); v_ = xb_ld(ctl + CW_XCC + cp); }
        const unsigned mine_ = 1u + xb_xcc_id();
        lnx_fast = (__ballot(C.tid < 8 && v_ == mine_) & 0xffull) == 0xffull ? 1 : 0;
        lnx_fast = __builtin_amdgcn_readfirstlane(C.wave == 0 ? lnx_fast : 0);
        LAS int* lf_ = (LAS int*)(C.lds + MISC_OFF + 96); if (C.tid == 0) *lf_ = lnx_fast; __syncthreads(); lnx_fast = *lf_; }
    const bool fuse_ln = (!MK_PER_PHASE) && C.G == 256;
    if (IN(4)) { pg8::Gemm g{MIX, (const bf16*)(ws + WS_WOUT0), DM, DM};
        if (fuse_ln) { pg8::PanelOrder S{C.wg}; pg8::EpiResLn E{XB, XB, 1.0f, P.in[5], P.in[6], (unsigned long long*)(ws + WS_LNX), lnx_fast, C.lds + LNX_OFF, ws + WS_X8}; E.stage_affine((C.wg >> 3) & 7);
            pg8::gemm_phase<pg8::EpiResLn, pg8::PanelOrder, false>(C.lds, g, S, E); }
        else { pg8::StaticOrder S; S.init(M, DM, C.G, C.wg); pg8::EpiRes E{XB, TB, 1.0f};
            pg8::gemm_phase<pg8::EpiRes, pg8::StaticOrder, false>(C.lds, g, S, E); } } SEAM(4);
    if (IN(5) && !fuse_ln) { p_layernorm<false, false, true>(C, TB, P.in[5], P.in[6], XB, nullptr, ws + WS_X8, nullptr, nullptr, nullptr, nullptr); }
    if (!fuse_ln) SEAM(5);
    if (IN(6)) { pg8::Gemm g{(const bf16*)(ws + WS_X8), (const bf16*)(ws + WS_WGU), DM, DM}; pg8::StaticOrder S; S.init(M, 2 * FFN, C.G, C.wg); pg8::EpiSwiglu8 E{ws + WS_HID, FFN, 44, 1.0f / (S8_X * S8_W1), 0};
        pg8::gemm_phase<pg8::EpiSwiglu8, pg8::StaticOrder, false, true>(C.lds, g, S, E); } SEAM(6);
    if (IN(7)) { pg8::Gemm g{(const bf16*)(ws + WS_HID), (const bf16*)(ws + WS_WDN), FFN, FFN};
        if (fuse_ln) { pg8::PanelOrder S{C.wg}; pg8::EpiResLn E{XB, XB, 1.0f / (S8_H * S8_W2), P.in[9], P.in[10], (unsigned long long*)(ws + WS_LNX) + 262144, lnx_fast, C.lds + LNX_OFF, nullptr}; E.stage_affine((C.wg >> 3) & 7);
            pg8::gemm_phase<pg8::EpiResLn, pg8::PanelOrder, false, true>(C.lds, g, S, E); }
        else { pg8::StaticOrder S; S.init(M, DM, C.G, C.wg); pg8::EpiRes E{XB, TB, 1.0f / (S8_H * S8_W2)};
            pg8::gemm_phase<pg8::EpiRes, pg8::StaticOrder, false, true>(C.lds, g, S, E); } } SEAM(7);
    if (IN(8) && !fuse_ln) { p_layernorm<false, false>(C, TB, P.in[9], P.in[10], XB, nullptr, nullptr, nullptr, nullptr, nullptr, nullptr); }
    if (!fuse_ln) SEAM(8);
    if (IN(9)) for (int rep_ = 0; rep_ < REP(9); ++rep_) { pg8::Gemm g{XB, (const bf16*)(ws + WS_WIN1), DM, DM}; pg8::StaticOrder S; S.init(M, 4096, C.G, C.wg); pg8::EpiGeluStats E{Zb, VST};
        pg8::gemm_phase<pg8::EpiGeluStats, pg8::StaticOrder, false>(C.lds, g, S, E); } SEAM(9);
    if (IN(10)) { for (int rep = 0; rep < REP(10); ++rep) p_sgu(C, Zb, SGb, VST, P.in[14], P.in[15], P.in[12], P.in[13]); } SEAM(10);
    if (IN(11)) { pg8::Gemm g{SGb, (const bf16*)(ws + WS_WOUT1), DM, DM};
        if (fuse_ln) { pg8::PanelOrder S{C.wg}; pg8::EpiResLn E{XB, XB, 1.0f, P.in[17], P.in[18], (unsigned long long*)(ws + WS_LNX) + 2 * 262144, lnx_fast, C.lds + LNX_OFF, ws + WS_X8}; E.stage_affine((C.wg >> 3) & 7);
            pg8::gemm_phase<pg8::EpiResLn, pg8::PanelOrder, false>(C.lds, g, S, E); }
        else { pg8::StaticOrder S; S.init(M, DM, C.G, C.wg); pg8::EpiRes E{XB, TB, 1.0f};
            pg8::gemm_phase<pg8::EpiRes, pg8::StaticOrder, false>(C.lds, g, S, E); } } SEAM(11);
    if (IN(12)) { if (fuse_ln) p_router(C, XB, P.in[19], CNT, LIST, GATE, (int*)(ws + WS_PPOS));
        else p_layernorm<false, true, true>(C, TB, P.in[17], P.in[18], XB, nullptr, ws + WS_X8, P.in[19], CNT, LIST, GATE, (int*)(ws + WS_PPOS)); } SEAM(12);
    bool flow = !MK_PER_PHASE && IN(13) && IN(14);
    if (IN(13)) for (int rep_ = 0; rep_ < REP(13); ++rep_) { moe_tables(C, CNT);
        pg8::Gemm g{(const bf16*)(ws + WS_X8), (const bf16*)(ws + WS_MGU), DM, DM}; pg8::MoeOrder S; S.rep = REP(17); S.nM = tbase[16] >> 8; S.nN = 11; S.nwg = S.nM * 11; S.G = C.G; S.c = C.wg; S.tile0 = 0; S.tbase = tbase; S.tcnt = tcnt; S.tileg = tileg; S.list = LIST;
        pg8::EpiSwiglu8 E{ws + WS_MHID, EPAD, 11, 1.0f / (S8_X * S8_W1), 1};
        LAS int* rt = (LAS int*)(C.lds + LNX_OFF); S.rowtab = rt; const int nmine = C.wg < S.nwg * S.rep ? (S.nwg * S.rep - C.wg + C.G - 1) / C.G : 0;
        flow = flow && (S.nwg * S.rep + C.G - 1) / C.G <= 12;
        const int rsig = S.nwg / C.G; const bool inside = flow && rsig >= 1 && nmine > rsig;
        S.fl = pg8::FlowSig{ctl + CW_SIG, bar.x, flow ? bar.st[0] : 1u, flow ? bar.st[1] : 1u}; S.arrive_ui = inside ? rsig - 1 : -1; S.rot = 0; S.dep_nwg = 0; S.dep_nN = 11; S.dep_rsig = 0;
        for (int base = 0; base < nmine; base += 12) { S.i0 = base; S.ilim = (nmine - base) < 12 ? (nmine - base) : 12;
            int tok[6]; int tid_o = C.tid; asm volatile("" : "+v"(tid_o));
#pragma unroll
            for (int k = 0; k < 6; ++k) { const int j = 2 * k + (C.wave >> 2); pg8::Unit u; (void)S.next(j < S.ilim ? j : 0, u); tok[k] = S.a_row_g(u, C.tid & 255); }
#pragma unroll
            for (int k = 0; k < 6; ++k) { const int idx = tid_o + 512 * k; if (idx < S.ilim * 256) rt[idx] = tok[k]; }
            __syncthreads();
            pg8::gemm_phase<pg8::EpiSwiglu8, pg8::MoeOrder, true, true, true>(C.lds, g, S, E); }
        if (flow) { asm volatile("s_waitcnt vmcnt(0)" ::: "memory"); __syncthreads(); if (C.tid == 0) { if (!inside) pg8::flow_arrive(S.fl, 0); pg8::flow_arrive(S.fl, 1); } } }
    if (!flow) SEAM(13);
    if (IN(14)) { if (!flow) moe_tables(C, CNT);
        pg8::Gemm g{MHID, (const bf16*)(ws + WS_MDN), EPAD, EPAD, 1};     pg8::MoeOrder S; S.rep = 1; S.nM = tbase[16] >> 8; S.nN = 8; S.nwg = S.nM * 8; S.G = C.G; S.c = C.wg; S.tile0 = 0; S.tbase = tbase; S.tcnt = tcnt; S.tileg = tileg; S.list = LIST; S.rowtab = nullptr; S.i0 = 0; S.ilim = 1 << 30;
        const int nwg13 = S.nM * 11;
        S.fl = pg8::FlowSig{ctl + CW_SIG, bar.x, flow ? bar.st[0] : 1u, flow ? bar.st[1] : 1u}; S.arrive_ui = -1; S.rot = flow ? 64 : 0; S.dep_nwg = flow ? nwg13 : 0; S.dep_nN = 11; S.dep_rsig = nwg13 / C.G;
        if (flow) S.c = (C.wg + C.G - nwg13 % C.G) % C.G;
        LAS float* gt = (LAS float*)(C.lds + LNX_OFF); const int nmine = S.c < S.nwg ? (S.nwg - S.c + C.G - 1) / C.G : 0;
        pg8::EpiMoePairs E{(bf16*)(ws + WS_OPAIR), gt, 1.0f / (S8_H * S8_W2), tbase, tcnt, tileg};
        for (int base = 0; base < nmine; base += 12) { S.i0 = base; S.ilim = (nmine - base) < 12 ? (nmine - base) : 12;
            float gv[6]; int tid_o = C.tid; asm volatile("" : "+v"(tid_o));
#pragma unroll
            for (int k = 0; k < 6; ++k) { const int j = 2 * k + (C.wave >> 2); pg8::Unit u; (void)S.next(j < S.ilim ? j : 0, u);
                const int gq = tileg[u.pm], pos = u.pm * 256 + (C.tid & 255) - tbase[gq], cq = tcnt[gq]; gv[k] = GATE[gq * LISTCAP + (pos < cq ? pos : cq - 1)]; }
#pragma unroll
            for (int k = 0; k < 6; ++k) { const int idx = tid_o + 512 * k; if (idx < S.ilim * 256) gt[idx] = gv[k]; }
            __syncthreads();
            pg8::gemm_phase<pg8::EpiMoePairs, pg8::MoeOrder, false, true, true>(C.lds, g, S, E); } } SEAM(14);
    if (IN(16)) { moe_tables(C, CNT); p_final_ln(C, XB, (const bf16*)(ws + WS_OPAIR), (const int*)(ws + WS_PPOS), P.in[22], P.in[23], OUT); }
    if (MK_PROBE_HI >= 0) { if (MK_PROBE_HI == 16 && C.tid == 0) PR_T1 = __builtin_amdgcn_s_memrealtime();
        if (C.wg == 0 && C.tid == 0) { const unsigned long long iv_ = MK_PROBE_EPI ? *(volatile LAS unsigned long long*)(C.lds + MISC_OFF + 80) : (PR_T1 - PR_T0); const unsigned long long until = __builtin_amdgcn_s_memrealtime() + (unsigned long long)MK_PROBE_AMP * iv_;
            while (__builtin_amdgcn_s_memrealtime() < until) __builtin_amdgcn_s_sleep(32); } }
#undef IN
#undef SEAM
}

extern "C" void kernel_launch(void* const* d_in, const int* in_sizes, int n_in, void* d_out, int out_size, void* d_ws, size_t ws_size, hipStream_t stream) {
    static int grid = 0;
    if (grid == 0) {
        if (n_in != 24 || in_sizes[0] != M * DM || out_size != M * DM || ws_size < WS_END) { fprintf(stderr, "kernel_launch: unexpected problem (n_in %d, in0 %d, out %d, ws %zu); nothing launched\n", n_in, n_in > 0 ? in_sizes[0] : -1, out_size, ws_size); grid = -1; return; }
        int dev = 0, cus = 0, per_cu = 0;
        if (hipGetDevice(&dev) != hipSuccess || hipDeviceGetAttribute(&cus, hipDeviceAttributeMultiprocessorCount, dev) != hipSuccess) { grid = -1; return; }
        if (hipFuncSetAttribute((const void*)fwd_kernel, hipFuncAttributeMaxDynamicSharedMemorySize, LDS_BYTES) != hipSuccess) { fprintf(stderr, "kernel_launch: hipFuncSetAttribute failed\n"); grid = -1; return; }
        if (hipOccupancyMaxActiveBlocksPerMultiprocessor(&per_cu, (const void*)fwd_kernel, 512, LDS_BYTES) != hipSuccess || per_cu < 1) { fprintf(stderr, "kernel_launch: occupancy query reports %d\n", per_cu); }
        (void)hipGetLastError();
        grid = cus;
    }
    if (grid < 0) return;
    if (hipMemsetAsync((char*)d_ws + WS_CTL, 0, CTL_ZERO_BYTES, stream) != hipSuccess) return;
    Ptrs p{};
    for (int i = 0; i < 24; ++i) p.in[i] = (const float*)d_in[i];
    p.out = (float*)d_out; p.ws = (unsigned char*)d_ws;
#if MK_PER_PHASE
    for (int k = 0; k < NPHASE; ++k) { p.ph_lo = k; p.ph_hi = k + 1; hipLaunchKernelGGL(fwd_kernel, dim3(grid), dim3(512), LDS_BYTES, stream, p); }
#else
    p.ph_lo = 0; p.ph_hi = NPHASE;
    hipLaunchKernelGGL(fwd_kernel, dim3(grid), dim3(512), LDS_BYTES, stream, p);
#endif
}
```
